# Optimizing an MI355X kernel written in HIP

```python
import math
import jax, jax.numpy as jnp
from jax import lax
import numpy as np

D_MODEL = 1024
BATCH = 8
SEQ = 4096
DEPTH = 1

N_META = 16
BLOCK = 128
WINDOW = 128
HEAD_DIM = 64
A_HEADS = D_MODEL // 256
A_V_DIM = 2 * HEAD_DIM
A_WIDTH = A_HEADS * A_V_DIM
B_HEADS = D_MODEL // 128
B_KV_HEADS = max(1, B_HEADS // 4)
B_GROUP = B_HEADS // B_KV_HEADS
B_WIDTH = B_HEADS * HEAD_DIM
D_FF = -(-8 * D_MODEL // (3 * 256)) * 256
EPS = 1e-6
QA_W = A_HEADS * 2 * HEAD_DIM
KA_W = A_HEADS * 2 * HEAD_DIM
VA_W = A_WIDTH
QB_W = B_WIDTH
KB_W = B_KV_HEADS * HEAD_DIM
VB_W = B_KV_HEADS * HEAD_DIM
GATE_W = D_MODEL
PROJ_W = QA_W + KA_W + VA_W + QB_W + KB_W + VB_W + 2 * GATE_W

kernel_name = "hybrid_diffattn_swa_gated_encoder"


def rms_norm(x, g):
    xf = x.astype(jnp.float32)
    y = xf * lax.rsqrt(jnp.mean(xf * xf, axis=-1, keepdims=True) + EPS)
    return (y * g.astype(jnp.float32)).astype(x.dtype)


def alibi_slopes(n):
    return jnp.asarray(2.0 ** (-8.0 * np.arange(1, n + 1) / n), dtype=jnp.float32)


def lambda_init_for(layer):
    return 0.8 - 0.6 * math.exp(-0.3 * layer)


def diff_attn_rows(q1, q2, k1, k2, v, qpos, kpos, key_real, slopes, lam):
    scale = HEAD_DIM ** -0.5
    dist = jnp.abs(qpos[:, None] - kpos[None, :]).astype(jnp.float32) * key_real[None, :]
    bias = -slopes[:, None, None] * dist[None]
    s1 = jnp.einsum('bqhd,bkhd->bhqk', q1, k1).astype(jnp.float32) * scale + bias
    s2 = jnp.einsum('bqhd,bkhd->bhqk', q2, k2).astype(jnp.float32) * scale + bias
    attn = jax.nn.softmax(s1, axis=-1) - lam * jax.nn.softmax(s2, axis=-1)
    return jnp.einsum('bhqk,bkhe->bqhe', attn.astype(v.dtype), v)


def differential_attention(q, k, v, lam_q1, lam_k1, lam_q2, lam_k2, subln_g, lambda_init):
    Bn, L = q.shape[0], q.shape[1]
    S = L - N_META
    nb = S // BLOCK
    pos = jnp.arange(L)
    key_real = (pos >= N_META).astype(jnp.float32)
    slopes = alibi_slopes(A_HEADS)
    lam = (jnp.exp(jnp.sum(lam_q1.astype(jnp.float32) * lam_k1.astype(jnp.float32)))
           - jnp.exp(jnp.sum(lam_q2.astype(jnp.float32) * lam_k2.astype(jnp.float32)))
           + lambda_init)
    q1, q2 = q[..., 0, :], q[..., 1, :]
    k1, k2 = k[..., 0, :], k[..., 1, :]

    def attend(a, b, p):
        return diff_attn_rows(a, b, k1, k2, v, p, pos, key_real, slopes, lam)

    y_meta = attend(q1[:, :N_META], q2[:, :N_META], pos[:N_META])

    def to_blocks(t):
        return t[:, N_META:].reshape(Bn, nb, BLOCK, *t.shape[2:]).swapaxes(0, 1)

    y_real = lax.map(lambda a: attend(*a),
                     (to_blocks(q1), to_blocks(q2), pos[N_META:].reshape(nb, BLOCK)))
    y_real = y_real.swapaxes(0, 1).reshape(Bn, S, A_HEADS, A_V_DIM)
    y = jnp.concatenate([y_meta, y_real], axis=1)
    y = rms_norm(y, subln_g) * (1.0 - lambda_init)
    return y.reshape(Bn, L, A_WIDTH)


def window_attn_blocks(q, k, v, qpos, kpos, kvalid, kreal, slopes, sink):
    scale = HEAD_DIM ** -0.5
    dt = jnp.abs(qpos[:, :, None] - kpos[:, None, :])
    visible = kvalid[:, None, :] & ((~kreal[:, None, :]) | (dt <= WINDOW))
    dist = jnp.where(kreal[:, None, :], dt, 0).astype(jnp.float32)
    bias = -slopes[None, :, :, None, None] * dist[:, None, None]
    s = jnp.einsum('bnqgrd,bnkgd->bngrqk', q, k).astype(jnp.float32) * scale + bias
    s = jnp.where(visible[None, :, None, None], s, -jnp.inf)
    sink_b = sink.astype(jnp.float32)[None, None, :, :, None, None]
    m = jnp.maximum(jnp.max(s, axis=-1, keepdims=True), sink_b)
    p = jnp.exp(s - m)
    denom = jnp.sum(p, axis=-1, keepdims=True) + jnp.exp(sink_b - m)
    return jnp.einsum('bngrqk,bnkgd->bnqgrd', (p / denom).astype(v.dtype), v)


def windowed_gqa(q, k, v, sink):
    Bn, L = q.shape[0], q.shape[1]
    S = L - N_META
    nb = S // BLOCK
    G, d = B_KV_HEADS, HEAD_DIM
    slopes = alibi_slopes(B_HEADS).reshape(B_KV_HEADS, B_GROUP)

    def band(t):
        tp = jnp.pad(t[:, N_META:], ((0, 0), (BLOCK, BLOCK), (0, 0), (0, 0)))
        tp = tp.reshape(Bn, nb + 2, BLOCK, G, d)
        win = jnp.concatenate([tp[:, j:j + nb] for j in range(3)], axis=2)
        meta = jnp.broadcast_to(t[:, None, :N_META], (Bn, nb, N_META, G, d))
        return jnp.concatenate([meta, win], axis=2)

    blk = jnp.arange(nb)[:, None]
    win_idx = (blk - 1) * BLOCK + jnp.arange(3 * BLOCK)[None, :]
    meta_pos = jnp.broadcast_to(jnp.arange(N_META)[None, :], (nb, N_META))
    kpos = jnp.concatenate([meta_pos, N_META + win_idx], axis=1)
    kvalid = jnp.concatenate([jnp.ones((nb, N_META), bool),
                              (win_idx >= 0) & (win_idx < S)], axis=1)
    kreal = jnp.concatenate([jnp.zeros((nb, N_META), bool),
                             jnp.ones((nb, 3 * BLOCK), bool)], axis=1)
    qpos = N_META + jnp.arange(S).reshape(nb, BLOCK)
    q_real = q[:, N_META:].reshape(Bn, nb, BLOCK, G, B_GROUP, d)
    y_real = window_attn_blocks(q_real, band(k), band(v), qpos, kpos, kvalid, kreal, slopes, sink)
    y_real = y_real.reshape(Bn, S, B_WIDTH)

    tk = N_META + BLOCK
    kpos_m = jnp.arange(tk)[None, :]
    y_meta = window_attn_blocks(q[:, None, :N_META], k[:, None, :tk], v[:, None, :tk],
                                jnp.arange(N_META)[None, :], kpos_m,
                                jnp.ones((1, tk), bool), kpos_m >= N_META, slopes, sink)
    y_meta = y_meta.reshape(Bn, N_META, B_WIDTH)
    return jnp.concatenate([y_meta, y_real], axis=1)


def mixer_block(h, w_in, lq1, lk1, lq2, lk2, subln_g, sink, w_ba, w_bb, w_o, lambda_init):
    Bn, L = h.shape[0], h.shape[1]
    proj = h @ w_in
    o = 0
    qa = proj[..., o:o + QA_W]; o += QA_W
    ka = proj[..., o:o + KA_W]; o += KA_W
    va = proj[..., o:o + VA_W]; o += VA_W
    qb = proj[..., o:o + QB_W]; o += QB_W
    kb = proj[..., o:o + KB_W]; o += KB_W
    vb = proj[..., o:o + VB_W]; o += VB_W
    ga = proj[..., o:o + GATE_W]; o += GATE_W
    gb = proj[..., o:o + GATE_W]
    y_a = differential_attention(qa.reshape(Bn, L, A_HEADS, 2, HEAD_DIM),
                                 ka.reshape(Bn, L, A_HEADS, 2, HEAD_DIM),
                                 va.reshape(Bn, L, A_HEADS, A_V_DIM),
                                 lq1, lk1, lq2, lk2, subln_g, lambda_init)
    y_b = windowed_gqa(qb.reshape(Bn, L, B_KV_HEADS, B_GROUP, HEAD_DIM),
                       kb.reshape(Bn, L, B_KV_HEADS, HEAD_DIM),
                       vb.reshape(Bn, L, B_KV_HEADS, HEAD_DIM),
                       sink.reshape(B_KV_HEADS, B_GROUP))
    merged = jax.nn.sigmoid(ga) * (y_a @ w_ba) + jax.nn.sigmoid(gb) * (y_b @ w_bb)
    return merged @ w_o


def swiglu(h, w_gate, w_up, w_down):
    return (jax.nn.silu(h @ w_gate) * (h @ w_up)) @ w_down


def setup_inputs(seed: int = 0) -> dict:
    key = jax.random.key(seed)
    ks = jax.random.split(key, 20)

    def w(k, shape, fan_in):
        return jax.random.normal(k, shape, jnp.float32) * (fan_in ** -0.5)

    def gain(k, shape):
        return 1.0 + 0.02 * jax.random.normal(k, shape, jnp.float32)

    return {
        "x": jax.random.normal(ks[0], (BATCH, SEQ, D_MODEL), jnp.float32),
        "meta_tokens": jax.random.normal(ks[1], (N_META, D_MODEL), jnp.float32),
        "norm_mix": gain(ks[2], (DEPTH, D_MODEL)),
        "w_in": w(ks[3], (DEPTH, D_MODEL, PROJ_W), D_MODEL),
        "lambda_q1": 0.1 * jax.random.normal(ks[4], (DEPTH, HEAD_DIM), jnp.float32),
        "lambda_k1": 0.1 * jax.random.normal(ks[5], (DEPTH, HEAD_DIM), jnp.float32),
        "lambda_q2": 0.1 * jax.random.normal(ks[6], (DEPTH, HEAD_DIM), jnp.float32),
        "lambda_k2": 0.1 * jax.random.normal(ks[7], (DEPTH, HEAD_DIM), jnp.float32),
        "subln_gain": gain(ks[8], (DEPTH, A_V_DIM)),
        "sink_logits": 0.5 * jax.random.normal(ks[9], (DEPTH, B_HEADS), jnp.float32),
        "w_branch_a": w(ks[10], (DEPTH, A_WIDTH, D_MODEL), A_WIDTH),
        "w_branch_b": w(ks[11], (DEPTH, B_WIDTH, D_MODEL), B_WIDTH),
        "w_out": w(ks[12], (DEPTH, D_MODEL, D_MODEL), D_MODEL),
        "norm_ffn": gain(ks[13], (DEPTH, D_MODEL)),
        "w_ff_gate": w(ks[14], (DEPTH, D_MODEL, D_FF), D_MODEL),
        "w_ff_up": w(ks[15], (DEPTH, D_MODEL, D_FF), D_MODEL),
        "w_ff_down": w(ks[16], (DEPTH, D_FF, D_MODEL), D_FF),
        "norm_final": gain(ks[17], (D_MODEL,)),
    }


def reference(x, meta_tokens, norm_mix, w_in, lambda_q1, lambda_k1, lambda_q2, lambda_k2,
              subln_gain, sink_logits, w_branch_a, w_branch_b, w_out, norm_ffn,
              w_ff_gate, w_ff_up, w_ff_down, norm_final):
    Bn = x.shape[0]
    meta = jnp.broadcast_to(meta_tokens.astype(x.dtype)[None], (Bn, N_META, x.shape[-1]))
    h = jnp.concatenate([meta, x], axis=1)
    for layer in range(DEPTH):
        h = h + mixer_block(rms_norm(h, norm_mix[layer]), w_in[layer],
                            lambda_q1[layer], lambda_k1[layer], lambda_q2[layer], lambda_k2[layer],
                            subln_gain[layer], sink_logits[layer],
                            w_branch_a[layer], w_branch_b[layer], w_out[layer],
                            lambda_init_for(layer))
        h = h + swiglu(rms_norm(h, norm_ffn[layer]), w_ff_gate[layer], w_ff_up[layer], w_ff_down[layer])
    return rms_norm(h, norm_final)[:, N_META:]
```

```cpp
#include <hip/hip_runtime.h>
#include <hip/hip_cooperative_groups.h>
#include <cstdio>
#include <cstdint>
namespace pg8 {
#define PG8_LAS __attribute__((address_space(3)))
typedef unsigned short bf16_t;
typedef short bf16x8 __attribute__((ext_vector_type(8)));
typedef float f32x4 __attribute__((ext_vector_type(4)));
typedef unsigned u32x4 __attribute__((ext_vector_type(4)));
constexpr int BM = 256, BK = 64, HALF = 128, HTB = HALF * BK * 2  , STAGE_BYTES = 8 * HTB, NXCD = 8, WGM = 8;

__host__ __device__ __forceinline__ int lds_byte(int r, int c) { const int st = (r >> 4) * 2 + (c >> 5), rr = r & 15, cc = c & 31, ob = rr * 64 + cc * 2; return st * 1024 + (ob ^ (((ob >> 9) & 1) << 5)); }
__host__ __device__ __forceinline__ void stage_rc(int b, int& R, int& C) { const int st = b / 1024, sb = b % 1024, swz = sb ^ (((sb >> 9) & 1) << 5); R = (st >> 1) * 16 + swz / 64; C = (st & 1) * 32 + (swz % 64) / 2; }
__host__ __device__ __forceinline__ int perm32(int rho) { const int n = rho >> 4, i = rho & 15; return 8 * (i >> 2) + 4 * n + (i & 3); }

struct Unit { int pm, pn, kh; };
struct Gemm { const bf16_t* A; const bf16_t* Bt; int M, N, K; int ld; };

struct StaticOrder {
    int nM, nN, nwg, G, c;
    __host__ __device__ void init(int M, int N, int G_, int c_) { nM = M / BM; nN = N / BM; nwg = nM * nN; G = G_; c = c_; }
    __host__ __device__ bool next(int i, Unit& u) const {
        const long L = (long)i * G + c; if (L >= nwg) return false;
        int wgid = (int)L; { const int q = nwg / NXCD, r = nwg % NXCD, xcd = wgid % NXCD, off = wgid / NXCD; wgid = (xcd < r ? xcd * (q + 1) : r * (q + 1) + (xcd - r) * q) + off; }
        const int nig = WGM * nN, gid = wgid / nig, fm = gid * WGM, gsz = (nM - fm) < WGM ? (nM - fm) : WGM;
        u.pm = fm + ((wgid % nig) % gsz); u.pn = (wgid % nig) / gsz; u.kh = 0; return true;
    }
    __device__ __forceinline__ void a_ready(const Unit&) const {}
    __device__ __forceinline__ void done(const Unit&) const {}
};

__device__ __forceinline__ unsigned cvt_pk_bf16(float lo, float hi) { unsigned r; asm volatile("v_cvt_pk_bf16_f32 %0, %1, %2" : "=v"(r) : "v"(lo), "v"(hi)); return r; }
template <class Epi, class Sched, bool ALIGN_EPI = false, bool SP2 = false>
__device__ __forceinline__ void gemm_phase(PG8_LAS unsigned char* lds, const Gemm g, const Sched& S, const Epi& E) {
    int tid_ = threadIdx.x; asm volatile("" : "+v"(tid_));
    const int tid = tid_, wid = __builtin_amdgcn_readfirstlane(tid >> 6), lane = tid & 63, wr = wid >> 2, wc = wid & 3, fr = lane & 15, fq = lane >> 4;
    const int K = g.ld ? g.ld : g.K, nt = g.K / BK;
    const size_t khstep = (size_t)g.K * 2;
    unsigned voffA[2], voffB[2];
#pragma unroll
    for (int i = 0; i < 2; ++i) { int R, C; stage_rc(tid * 16 + i * 8192, R, C); const int Rb = Epi::PERM ? ((R & ~31) + perm32(R & 31)) : R;
        voffA[i] = (unsigned)(R * K + C) * 2u; voffB[i] = (unsigned)(Rb * K + C) * 2u; }
    const size_t kstep = (size_t)(BK * 2);
    const size_t hstep = (size_t)HALF * K * 2;
    const size_t tstep = 2 * hstep;
    const unsigned ldsw = (unsigned)wid * 1024u;
    const int aoff = lds_byte(wr * 64 + fr, fq * 8), boff = lds_byte(wc * 32 + fr, fq * 8);
#define PG8_SA(b, h) (((b) * 2 + (h)) * HTB)
#define PG8_SB(b, h) ((4 + (b) * 2 + (h)) * HTB)
#define PG8_STAGE(bufoff, gbase, voff) do { _Pragma("unroll") for (int _i = 0; _i < 2; ++_i) \
        __builtin_amdgcn_global_load_lds((const unsigned*)((const char*)(gbase) + (voff)[_i]), (PG8_LAS unsigned*)(lds + (bufoff) + ldsw + _i * 8192), 16, 0, 0); } while (0)
#define PG8_LDA(dst, b, h) do { _Pragma("unroll") for (int m = 0; m < 4; ++m) _Pragma("unroll") for (int k = 0; k < 2; ++k) dst[m][k] = *(const PG8_LAS bf16x8*)(lds + PG8_SA(b, h) + aoff + m * 2048 + k * 1024); } while (0)
#define PG8_LDB(dst, b, h) do { _Pragma("unroll") for (int n = 0; n < 2; ++n) _Pragma("unroll") for (int k = 0; k < 2; ++k) dst[n][k] = *(const PG8_LAS bf16x8*)(lds + PG8_SB(b, h) + boff + n * 2048 + k * 1024); } while (0)
#define PG8_MMA(ai, bj, At, Bt) do { __builtin_amdgcn_s_setprio(1); _Pragma("unroll") for (int m = 0; m < 4; ++m) _Pragma("unroll") for (int n = 0; n < 2; ++n) _Pragma("unroll") for (int k = 0; k < 2; ++k) \
        acc[ai][bj][m][n] = __builtin_amdgcn_mfma_f32_16x16x32_bf16(Bt[n][k], At[m][k], acc[ai][bj][m][n], 0, 0, 0); __builtin_amdgcn_s_setprio(0); } while (0)
#define PG8_WAIT_V(n) asm volatile("s_waitcnt vmcnt(" #n ")" ::: "memory")
#define PG8_WAIT_L(n) asm volatile("s_waitcnt lgkmcnt(" #n ")" ::: "memory")
#define PG8_BAR __builtin_amdgcn_s_barrier()
#define PG8_SCHED __builtin_amdgcn_sched_barrier(0)
    Unit cur, nxt; int ui = 0;
    if (!S.next(0, cur)) return;
    f32x4 acc[2][2][4][2];
#pragma unroll
    for (int a = 0; a < 2; ++a)
#pragma unroll
        for (int b = 0; b < 2; ++b)
#pragma unroll
            for (int m = 0; m < 4; ++m)
#pragma unroll
                for (int n = 0; n < 2; ++n) acc[a][b][m][n] = (f32x4){0.f, 0.f, 0.f, 0.f};
    bf16x8 At[4][2], B0[2][2], B1[2][2];
    const char* cA = (const char*)g.A + (size_t)cur.pm * tstep + cur.kh * khstep; const char* cB = (const char*)g.Bt + (size_t)cur.pn * tstep + cur.kh * khstep;
    S.a_ready(cur);
    if constexpr (SP2) {
        PG8_STAGE(PG8_SB(0, 0), cB, voffB); PG8_STAGE(PG8_SB(0, 1), cB + hstep, voffB); PG8_STAGE(PG8_SA(0, 0), cA, voffA); PG8_STAGE(PG8_SA(0, 1), cA + hstep, voffA);
        if (wr == 1) PG8_BAR;
        PG8_WAIT_V(2); PG8_BAR;
        PG8_STAGE(PG8_SB(1, 0), cB + kstep, voffB); PG8_STAGE(PG8_SA(1, 0), cA + kstep, voffA); PG8_STAGE(PG8_SB(1, 1), cB + hstep + kstep, voffB);
        PG8_WAIT_V(6); PG8_BAR;
    } else {
        PG8_STAGE(PG8_SB(0, 0), cB, voffB); PG8_STAGE(PG8_SA(0, 0), cA, voffA); PG8_STAGE(PG8_SB(0, 1), cB + hstep, voffB); PG8_STAGE(PG8_SA(0, 1), cA + hstep, voffA);
        if (wr == 1) PG8_BAR;
        PG8_WAIT_V(4); PG8_BAR;
        PG8_STAGE(PG8_SB(1, 0), cB + kstep, voffB); PG8_STAGE(PG8_SA(1, 0), cA + kstep, voffA); PG8_STAGE(PG8_SB(1, 1), cB + hstep + kstep, voffB);
        PG8_WAIT_V(6); PG8_BAR;
    }
    for (;;) {
        const bool has_next = S.next(ui + 1, nxt);
        const char* nA = has_next ? (const char*)g.A + (size_t)nxt.pm * tstep + nxt.kh * khstep : cA; const char* nB = has_next ? (const char*)g.Bt + (size_t)nxt.pn * tstep + nxt.kh * khstep : cB;
        for (int t = 0; t < nt; t += 2) {
            const bool last = (t == nt - 2);
            const char* a1 = cA + (size_t)(t + 1) * kstep;
            const char* a2 = last ? nA : cA + (size_t)(t + 2) * kstep; const char* b2 = last ? nB : cB + (size_t)(t + 2) * kstep;
            const char* a3 = a2 + kstep; const char* b3 = b2 + kstep;
            if (last && has_next) S.a_ready(nxt);
            if constexpr (SP2) {
            PG8_LDB(B0, 0, 0); PG8_LDB(B1, 0, 1); PG8_SCHED; PG8_LDA(At, 0, 0); PG8_STAGE(PG8_SA(1, 1), a1 + hstep, voffA);
            PG8_WAIT_V(8); PG8_WAIT_L(0); PG8_BAR; PG8_MMA(0, 0, At, B0); PG8_MMA(0, 1, At, B1); PG8_BAR; PG8_SCHED;
            PG8_LDA(At, 0, 1); PG8_STAGE(PG8_SB(0, 0), b2, voffB); PG8_STAGE(PG8_SB(0, 1), b2 + hstep, voffB); PG8_STAGE(PG8_SA(0, 0), a2, voffA);
            PG8_WAIT_V(8); PG8_WAIT_L(0); PG8_BAR; PG8_MMA(1, 0, At, B0); PG8_MMA(1, 1, At, B1); PG8_BAR; PG8_SCHED;
            PG8_LDB(B0, 1, 0); PG8_LDB(B1, 1, 1); PG8_SCHED; PG8_LDA(At, 1, 0); PG8_STAGE(PG8_SA(0, 1), a2 + hstep, voffA);
            PG8_WAIT_V(8); PG8_WAIT_L(0); PG8_BAR; PG8_MMA(0, 0, At, B0); PG8_MMA(0, 1, At, B1); PG8_BAR; PG8_SCHED;
            PG8_LDA(At, 1, 1); PG8_STAGE(PG8_SB(1, 0), b3, voffB); PG8_STAGE(PG8_SB(1, 1), b3 + hstep, voffB); PG8_STAGE(PG8_SA(1, 0), a3, voffA);
            PG8_WAIT_V(8); PG8_WAIT_L(0); PG8_BAR; PG8_MMA(1, 0, At, B0); PG8_MMA(1, 1, At, B1); PG8_BAR; PG8_SCHED;
            } else {
            PG8_LDB(B0, 0, 0); PG8_SCHED; PG8_LDA(At, 0, 0); PG8_STAGE(PG8_SA(1, 1), a1 + hstep, voffA);
            PG8_WAIT_L(8); PG8_BAR; PG8_WAIT_L(0); PG8_MMA(0, 0, At, B0); PG8_BAR; PG8_SCHED;
            PG8_LDB(B1, 0, 1); PG8_STAGE(PG8_SB(0, 0), b2, voffB);
            PG8_BAR; PG8_WAIT_L(0); PG8_MMA(0, 1, At, B1); PG8_BAR;
            PG8_LDA(At, 0, 1); PG8_STAGE(PG8_SA(0, 0), a2, voffA);
            PG8_BAR; PG8_WAIT_L(0); PG8_MMA(1, 0, At, B0); PG8_BAR; PG8_SCHED;
            PG8_STAGE(PG8_SB(0, 1), b2 + hstep, voffB);
            PG8_WAIT_V(6); PG8_BAR; PG8_MMA(1, 1, At, B1); PG8_BAR;
            PG8_LDB(B0, 1, 0); PG8_SCHED; PG8_LDA(At, 1, 0); PG8_STAGE(PG8_SA(0, 1), a2 + hstep, voffA);
            PG8_WAIT_L(8); PG8_BAR; PG8_WAIT_L(0); PG8_MMA(0, 0, At, B0); PG8_BAR; PG8_SCHED;
            PG8_LDB(B1, 1, 1); PG8_STAGE(PG8_SB(1, 0), b3, voffB);
            PG8_BAR; PG8_WAIT_L(0); PG8_MMA(0, 1, At, B1); PG8_BAR;
            PG8_LDA(At, 1, 1); PG8_STAGE(PG8_SA(1, 0), a3, voffA);
            PG8_BAR; PG8_WAIT_L(0); PG8_MMA(1, 0, At, B0); PG8_BAR; PG8_SCHED;
            PG8_STAGE(PG8_SB(1, 1), b3 + hstep, voffB);
            PG8_WAIT_V(6); PG8_BAR; PG8_MMA(1, 1, At, B1); PG8_BAR;
            }
        }
        if constexpr (ALIGN_EPI) { if (wr == 0) PG8_BAR; }
        if constexpr (!Epi::AFTER_DRAIN) { E(acc, cur, wr, wc, fr, fq); S.done(cur); }
        if (!has_next) break;
        if (!Epi::HAS_MID || cur.kh != 0) {
#pragma unroll
        for (int a = 0; a < 2; ++a)
#pragma unroll
            for (int b = 0; b < 2; ++b)
#pragma unroll
                for (int m = 0; m < 4; ++m)
#pragma unroll
                    for (int n = 0; n < 2; ++n) acc[a][b][m][n] = (f32x4){0.f, 0.f, 0.f, 0.f};
        }
        cur = nxt; cA = nA; cB = nB; ++ui;
        if constexpr (ALIGN_EPI) { if (wr == 1) PG8_BAR; }
    }
    PG8_WAIT_V(0);
    if constexpr (!ALIGN_EPI) { if (wr == 0) PG8_BAR; }
    PG8_BAR;
    if constexpr (Epi::AFTER_DRAIN) { E.fused(acc, cur, wr, wc, fr, fq, lds, wid, lane); S.done(cur); }
#undef PG8_SA
#undef PG8_SB
#undef PG8_STAGE
#undef PG8_LDA
#undef PG8_LDB
#undef PG8_MMA
#undef PG8_WAIT_V
#undef PG8_WAIT_L
#undef PG8_BAR
#undef PG8_SCHED
}
}

namespace cg = cooperative_groups;
#define LAS __attribute__((address_space(3)))
typedef unsigned short bf16_t;
typedef short bf16x8 __attribute__((ext_vector_type(8)));
typedef short s16x4 __attribute__((ext_vector_type(4)));
typedef float f32x4 __attribute__((ext_vector_type(4)));
typedef float f32x16 __attribute__((ext_vector_type(16)));
typedef unsigned u32x4 __attribute__((ext_vector_type(4)));
typedef unsigned u32x2 __attribute__((ext_vector_type(2)));

constexpr int D_MODEL = 1024, BATCH = 8, SEQ = 4096, N_META = 16;
constexpr int M_REAL = BATCH * SEQ;
constexpr int M_PAD = M_REAL + 256;
constexpr int PROJ_W = 3072, D_FF = 2816;
constexpr int PROJ_N = 4352;
constexpr int C_QA = 0, C_QB = 512, C_GA = 1024, C_GB = 2048;
constexpr float EPS = 1e-6f, LOG2E = 1.4426950408889634f, QSCALE = 0.125f * LOG2E;
constexpr float LAMBDA_INIT = 0.2f;

constexpr size_t MiB = 1u << 20;
constexpr size_t WS_WIN = 0, WS_WBA = 9 * MiB, WS_WBB = 10 * MiB, WS_WO = 11 * MiB, WS_WGU = 13 * MiB, WS_WD = 24 * MiB;
constexpr size_t WS_BAR = 31 * MiB;
constexpr size_t WS_STAT = 30 * MiB;
constexpr size_t WS_A = 32 * MiB;
constexpr size_t WS_Y = 97 * MiB;
constexpr size_t WS_P = 161 * MiB;
constexpr size_t WS_KA = 355 * MiB, WS_VA = 387 * MiB, WS_KB = 419 * MiB, WS_VB = 427 * MiB;
constexpr size_t WS_KAM = 435 * MiB, WS_VAM = WS_KAM + 65536, WS_KBM = WS_VAM + 65536, WS_VBM = WS_KBM + 16384;
constexpr size_t WS_END = 436 * MiB;
static_assert(WS_P + (size_t)M_PAD * PROJ_W * 2 <= WS_KA && WS_P + (size_t)M_REAL * D_FF * 2 <= WS_KA, "ws map");

constexpr int LDS_BYTES = 131072 + 8192;

struct Params {
    const float* x; const float* meta; const float* norm_mix; const float* w_in;
    const float* lq1; const float* lk1; const float* lq2; const float* lk2;
    const float* subln; const float* sink; const float* w_ba; const float* w_bb; const float* w_o;
    const float* norm_ffn; const float* w_g; const float* w_u; const float* w_d; const float* norm_final;
    float* out; unsigned char* ws;
};

__device__ __forceinline__ float bf2f(unsigned short v) { return __uint_as_float((unsigned)v << 16); }
typedef float f32x2_t __attribute__((ext_vector_type(2))); typedef __bf16 bf16x2_t __attribute__((ext_vector_type(2)));
__device__ __forceinline__ unsigned cvtpk(float lo, float hi) { f32x2_t v = {lo, hi}; bf16x2_t b = __builtin_convertvector(v, bf16x2_t); return __builtin_bit_cast(unsigned, b); }
__device__ __forceinline__ float wave_sum(float v) {
#pragma unroll
    for (int o = 1; o < 64; o <<= 1) v += __shfl_xor(v, o);
    return v;
}
__device__ __forceinline__ float half_max(float v) { auto rr = __builtin_amdgcn_permlane32_swap(__float_as_uint(v), __float_as_uint(v), false, false); return fmaxf(__uint_as_float(rr[0]), __uint_as_float(rr[1])); }
__device__ __forceinline__ float half_sum(float v) { auto rr = __builtin_amdgcn_permlane32_swap(__float_as_uint(v), __float_as_uint(v), false, false); return __uint_as_float(rr[0]) + __uint_as_float(rr[1]); }
__device__ __forceinline__ float sigmoidf_(float v) { return __builtin_amdgcn_rcpf(1.f + __builtin_amdgcn_exp2f(-v * LOG2E)); }

__device__ __forceinline__ void transpose_item(const float* __restrict__ W, int K, int N, const float* __restrict__ gain, bf16_t* __restrict__ WT,
                                               int dst_row0, int k0, int n0, LAS float* scr, int lane, int ldw = 0, int kdst = 0) {
    if (ldw == 0) ldw = K;
    float wv[32];
#pragma unroll
    for (int i = 0; i < 32; ++i) wv[i] = W[(size_t)(k0 + 2 * i + (lane >> 5)) * N + n0 + (lane & 31)];
#pragma unroll
    for (int i = 0; i < 32; ++i) { const int kk = 2 * i + (lane >> 5); const float g = gain ? gain[k0 + kk] : 1.f; scr[kk * 33 + (lane & 31)] = wv[i] * g; }
    asm volatile("s_waitcnt lgkmcnt(0)" ::: "memory");
    const int c = lane & 7;
#pragma unroll
    for (int j = 0; j < 4; ++j) { const int n = (lane >> 3) + 8 * j; const LAS float* s = scr + (8 * c) * 33 + n;
        u32x4 o; o.x = cvtpk(s[0 * 33], s[1 * 33]); o.y = cvtpk(s[2 * 33], s[3 * 33]); o.z = cvtpk(s[4 * 33], s[5 * 33]); o.w = cvtpk(s[6 * 33], s[7 * 33]);
        *(u32x4*)(WT + (size_t)(dst_row0 + n) * ldw + kdst + k0 + 8 * c) = o; }
    asm volatile("s_waitcnt lgkmcnt(0)" ::: "memory");
}

constexpr int W_I_IN = 16 * 136, W_I_BA = 8 * 32, W_I_O = 16 * 32, W_I_G = 16 * 88, W_I_D = 44 * 32;
constexpr int W_ITEMS_EARLY = W_I_IN + 2 * W_I_BA + W_I_O, W_ITEMS = W_ITEMS_EARLY + 2 * W_I_G + W_I_D;
__device__ __forceinline__ void weight_items(const Params& p, LAS unsigned char* lds, int first, int last, int gw, int NGW, int wave, int lane);
__device__ __forceinline__ void p0_prologue_rows(const Params& p, int gw, int NGW, int lane);
__device__ __forceinline__ void p0_prologue(const Params& p, LAS unsigned char* lds, int gw, int NGW, int wave, int lane) {
    p0_prologue_rows(p, gw, NGW, lane);
    weight_items(p, lds, 0, W_ITEMS_EARLY, gw, NGW, wave, lane);
}
__device__ __forceinline__ void weight_items(const Params& p, LAS unsigned char* lds, int first, int last, int gw, int NGW, int wave, int lane) {
    unsigned char* ws = p.ws;
    LAS float* scr = (LAS float*)(lds + wave * 16384);
    constexpr int I_IN = W_I_IN, I_BA = W_I_BA, I_O = W_I_O, I_G = W_I_G;
    for (int it = first + gw; it < last; it += NGW) {
        int r = it;
        if (r < I_IN) { const int kb = r / 136, nb = r % 136; transpose_item(p.w_in, 1024, PROJ_N, p.norm_mix, (bf16_t*)(ws + WS_WIN), nb * 32, kb * 64, nb * 32, scr, lane); continue; } r -= I_IN;
        if (r < I_BA) { const int kb = r / 32, nb = r % 32; transpose_item(p.w_ba, 512, 1024, nullptr, (bf16_t*)(ws + WS_WBA), nb * 32, kb * 64, nb * 32, scr, lane, 1024, 0); continue; } r -= I_BA;
        if (r < I_BA) { const int kb = r / 32, nb = r % 32; transpose_item(p.w_bb, 512, 1024, nullptr, (bf16_t*)(ws + WS_WBA), nb * 32, kb * 64, nb * 32, scr, lane, 1024, 512); continue; } r -= I_BA;
        if (r < I_O) { const int kb = r / 32, nb = r % 32; transpose_item(p.w_o, 1024, 1024, nullptr, (bf16_t*)(ws + WS_WO), nb * 32, kb * 64, nb * 32, scr, lane); continue; } r -= I_O;
        if (r < 2 * I_G) { const int up = r >= I_G; if (up) r -= I_G; const int kb = r / 88, nb = r % 88, n0 = nb * 32;
            transpose_item(up ? p.w_u : p.w_g, 1024, D_FF, p.norm_ffn, (bf16_t*)(ws + WS_WGU), 256 * (n0 >> 7) + (n0 & 127) + (up ? 128 : 0), kb * 64, n0, scr, lane); continue; } r -= 2 * I_G;
        { const int kb = r / 32, nb = r % 32; transpose_item(p.w_d, D_FF, 1024, nullptr, (bf16_t*)(ws + WS_WD), nb * 32, kb * 64, nb * 32, scr, lane); }
    }
}
__device__ __forceinline__ void p0_prologue_rows(const Params& p, int gw, int NGW, int lane) {
    unsigned char* ws = p.ws;
    bf16_t* HB = (bf16_t*)(ws + WS_A); float* rstd1 = (float*)(ws + WS_STAT);
    for (int m0 = gw; m0 < M_REAL; m0 += 4 * NGW) {
        f32x4 v[4][4];
#pragma unroll
        for (int q = 0; q < 4; ++q) { const int m = m0 + q * NGW; const f32x4* xr = (const f32x4*)(p.x + (size_t)(m < M_REAL ? m : m0) * D_MODEL) + lane;
#pragma unroll
            for (int j = 0; j < 4; ++j) v[q][j] = xr[64 * j]; }
#pragma unroll
        for (int q = 0; q < 4; ++q) { const int m = m0 + q * NGW; if (m >= M_REAL) break;
            float s = 0.f;
#pragma unroll
            for (int j = 0; j < 4; ++j) s += (v[q][j].x * v[q][j].x + v[q][j].y * v[q][j].y) + (v[q][j].z * v[q][j].z + v[q][j].w * v[q][j].w);
            s = wave_sum(s);
            if (lane == 0) rstd1[m] = __builtin_amdgcn_rsqf(s * (1.f / D_MODEL) + EPS);
            unsigned long long* o8 = (unsigned long long*)(HB + (size_t)m * D_MODEL) + lane;
#pragma unroll
            for (int j = 0; j < 4; ++j) o8[64 * j] = (unsigned long long)cvtpk(v[q][j].x, v[q][j].y) | ((unsigned long long)cvtpk(v[q][j].z, v[q][j].w) << 32); }
    }
    for (int m = M_REAL + gw; m < M_PAD; m += NGW) {
        unsigned long long* o8 = (unsigned long long*)(HB + (size_t)m * D_MODEL) + lane;
        if (m >= M_REAL + N_META) {
#pragma unroll
            for (int j = 0; j < 4; ++j) o8[64 * j] = 0ull;
            if (lane == 0) rstd1[m] = 0.f;
            continue;
        }
        const f32x4* xr = (const f32x4*)(p.meta + (size_t)(m - M_REAL) * D_MODEL) + lane;
        f32x4 v[4]; float s = 0.f;
#pragma unroll
        for (int j = 0; j < 4; ++j) { v[j] = xr[64 * j]; s += (v[j].x * v[j].x + v[j].y * v[j].y) + (v[j].z * v[j].z + v[j].w * v[j].w); }
        s = wave_sum(s);
        if (lane == 0) rstd1[m] = __builtin_amdgcn_rsqf(s * (1.f / D_MODEL) + EPS);
#pragma unroll
        for (int j = 0; j < 4; ++j) o8[64 * j] = (unsigned long long)cvtpk(v[j].x, v[j].y) | ((unsigned long long)cvtpk(v[j].z, v[j].w) << 32);
    }
    float* ss = (float*)(ws + WS_STAT) + M_PAD;
    for (int i = gw * 64 + lane; i < 2 * M_REAL + 256; i += NGW * 64) ss[i] = 0.f;
}

template <int KW, int DV, bool DMA> struct AttGeo {
    static constexpr int KP = DMA ? KW * 2 : KW * 2 + 16, VP = DMA ? DV * 2 : DV * 2 + 64, KB = 64 * KP, STG = KB + 64 * VP, NST = DMA ? 4 : 3;
    static constexpr int KCH = KW / 8, VCH = DV / 8, ND = DV / 32, NKR = KW / 64, NVR = DV / 64;
};
__device__ __forceinline__ void glds16(const void* gsrc, unsigned lds_dst) { unsigned keep;
    asm volatile("s_mov_b32 %0, m0\n\ts_mov_b32 m0, %2\n\ts_nop 0\n\tglobal_load_lds_dwordx4 %1, off\n\ts_mov_b32 m0, %0" : "=&s"(keep) : "v"(gsrc), "s"(lds_dst) : "memory"); }
template <int KW, int DV, bool DMA>
__device__ __forceinline__ void att_pv(LAS unsigned char* sv, const int (&voffs)[DV / 32], const bf16x8 (&pf)[4], f32x16 (&O)[DV / 32]) {
    typedef AttGeo<KW, DV, DMA> G;
#pragma unroll
    for (int ks = 0; ks < 4; ++ks)
#pragma unroll
        for (int d0 = 0; d0 < G::ND; ++d0) {
            const s16x4 lo = __builtin_bit_cast(s16x4, __builtin_amdgcn_ds_read_tr16_b64_v4i16((LAS s16x4*)(sv + voffs[d0] + (16 * ks) * G::VP)));
            const s16x4 hi = __builtin_bit_cast(s16x4, __builtin_amdgcn_ds_read_tr16_b64_v4i16((LAS s16x4*)(sv + voffs[d0] + (16 * ks + 8) * G::VP)));
            const bf16x8 vf = __builtin_shufflevector(lo, hi, 0, 1, 2, 3, 4, 5, 6, 7);
            O[d0] = __builtin_amdgcn_mfma_f32_32x32x16_bf16(vf, pf[ks], O[d0], 0, 0, 0);
        }
}
template <int KW, int DV, bool WIN, int MODE, bool HAS_PV, bool DMA>
__device__ __forceinline__ void att_step(LAS unsigned char* sk, LAS unsigned char* sv, LAS unsigned char* sw, bool do_load, const bf16_t* __restrict__ gk, const bf16_t* __restrict__ gv, int tid,
                                         const bf16x8 (&qf)[4], f32x16 (&O)[DV / 32], bf16x8 (&pf)[4], float& mref, float& lsum, bool& started,
                                         float sl2, float dbase, const int (&koffs)[4], const int (&voffs)[DV / 32], const int (&dsrc)[4]) {
    typedef AttGeo<KW, DV, DMA> G;
    constexpr float NEG = -1e30f, THR = 32.f;
    u32x4 kreg[G::NKR], vreg[G::NVR];
    if constexpr (DMA) {
        const unsigned wdst = (unsigned)__builtin_amdgcn_readfirstlane((int)(unsigned)(size_t)sw + (tid >> 6) * 2048);
        glds16(gk + dsrc[0], wdst); glds16(gk + dsrc[1], wdst + 1024);
        glds16(gv + dsrc[2], wdst + G::KB); glds16(gv + dsrc[3], wdst + G::KB + 1024);
    } else {
#pragma unroll
        for (int c = 0; c < G::NKR; ++c) kreg[c] = *(const u32x4*)(gk + (tid + 512 * c) * 8);
#pragma unroll
        for (int c = 0; c < G::NVR; ++c) vreg[c] = *(const u32x4*)(gv + (tid + 512 * c) * 8);
    }
    f32x16 S[2];
    {
        float c0 = -mref;
        if (MODE == 1) c0 = fmaf(-sl2, dbase, -mref);
        if (MODE == 3) c0 = fmaf(sl2, dbase, -mref);
        bf16x8 kf[8];
#pragma unroll
        for (int ks = 0; ks < 4; ++ks)
#pragma unroll
            for (int blk = 0; blk < 2; ++blk) kf[2 * ks + blk] = *(const LAS bf16x8*)(sk + koffs[ks] + blk * 32 * G::KP);
        asm volatile("" : "+v"(c0));
        f32x16 Ct;
#pragma unroll
        for (int i = 0; i < 16; ++i) Ct[i] = c0;
        __builtin_amdgcn_sched_barrier(0);
        S[0] = __builtin_amdgcn_mfma_f32_32x32x16_bf16(kf[0], qf[0], Ct, 0, 0, 0);
        S[1] = __builtin_amdgcn_mfma_f32_32x32x16_bf16(kf[1], qf[0], Ct, 0, 0, 0);
#pragma unroll
        for (int ks = 1; ks < 4; ++ks)
#pragma unroll
            for (int blk = 0; blk < 2; ++blk) S[blk] = __builtin_amdgcn_mfma_f32_32x32x16_bf16(kf[2 * ks + blk], qf[ks], S[blk], 0, 0, 0);
    }
    if (MODE == 0) {
#pragma unroll
        for (int i = 0; i < 16; ++i) { if (i >= 8) S[0][i] = NEG; S[1][i] = NEG; }
    } else if (MODE == 2) {
#pragma unroll
        for (int blk = 0; blk < 2; ++blk)
#pragma unroll
            for (int i = 0; i < 16; ++i) {
                const float d = fabsf(dbase - (float)(32 * blk + (i & 3) + 8 * (i >> 2)));
                float v = fmaf(-sl2, d, S[blk][i]);
                if (WIN) v = (d <= 128.f) ? v : NEG;
                S[blk][i] = v;
            }
    } else {
#pragma unroll
        for (int blk = 0; blk < 2; ++blk)
#pragma unroll
            for (int i = 0; i < 16; ++i) { S[blk][i] = fmaf((MODE == 1) ? sl2 : -sl2, (float)(32 * blk + (i & 3) + 8 * (i >> 2)), S[blk][i]); asm volatile("" : "+v"(S[blk][i])); }
    }
    bool resc = false; float al = 1.f;
    if constexpr (!DMA) {
    float rm = fmaxf(fmaxf(S[0][0], S[0][1]), S[1][0]);
#pragma unroll
    for (int i = 2; i < 16; i += 2) rm = fmaxf(fmaxf(rm, S[0][i]), S[0][i + 1]);
    rm = fmaxf(rm, S[1][1]);
#pragma unroll
    for (int i = 2; i < 16; i += 2) rm = fmaxf(fmaxf(rm, S[1][i]), S[1][i + 1]);
    rm = half_max(rm);
    if (!started || __any(rm > THR)) {
        const float dl = !started ? rm : fmaxf(rm, 0.f);
        mref += dl;
#pragma unroll
        for (int blk = 0; blk < 2; ++blk)
#pragma unroll
            for (int i = 0; i < 16; ++i) S[blk][i] -= dl;
        al = started ? __builtin_amdgcn_exp2f(-dl) : 1.f;
        lsum *= al;
        resc = true;
    }
    }
    started = true;
    __builtin_amdgcn_sched_barrier(0);
    unsigned pw[16];
    float sum0 = 0.f, sum1 = 0.f;
    if (HAS_PV) {
        constexpr int NM = 4 * G::ND, EPG = 32 / NM, PD = 4;
        bf16x8 vfr[NM];
#define ATT_VRD(m) do { const int ks_ = (m) / G::ND, d0_ = (m) % G::ND; \
            const s16x4 lo_ = __builtin_bit_cast(s16x4, __builtin_amdgcn_ds_read_tr16_b64_v4i16((LAS s16x4*)(sv + voffs[d0_] + (16 * ks_) * G::VP))); \
            const s16x4 hi_ = __builtin_bit_cast(s16x4, __builtin_amdgcn_ds_read_tr16_b64_v4i16((LAS s16x4*)(sv + voffs[d0_] + (16 * ks_ + 8) * G::VP))); \
            vfr[m] = __builtin_shufflevector(lo_, hi_, 0, 1, 2, 3, 4, 5, 6, 7); } while (0)
#pragma unroll
        for (int m = 0; m < PD; ++m) ATT_VRD(m);
        __builtin_amdgcn_sched_barrier(0);
#pragma unroll
        for (int m = 0; m < NM; ++m) {
            if (m + PD < NM) ATT_VRD(m + PD);
            O[m % G::ND] = __builtin_amdgcn_mfma_f32_32x32x16_bf16(vfr[m], pf[m / G::ND], O[m % G::ND], 0, 0, 0);
#pragma unroll
            for (int e = 0; e < EPG; e += 2) {
                const int idx = m * EPG + e, blk = idx >> 4, i = idx & 15;
                const float p0 = __builtin_amdgcn_exp2f(S[blk][i]), p1 = __builtin_amdgcn_exp2f(S[blk][i + 1]);
                sum0 += p0; sum1 += p1;
                pw[idx >> 1] = cvtpk(p0, p1);
                asm volatile("" : "+v"(pw[idx >> 1]), "+v"(sum0), "+v"(sum1));
            }
            __builtin_amdgcn_sched_barrier(0);
        }
#undef ATT_VRD
    } else {
#pragma unroll
        for (int idx = 0; idx < 32; idx += 2) {
            const int blk = idx >> 4, i = idx & 15;
            const float p0 = __builtin_amdgcn_exp2f(S[blk][i]), p1 = __builtin_amdgcn_exp2f(S[blk][i + 1]);
            sum0 += p0; sum1 += p1;
            pw[idx >> 1] = cvtpk(p0, p1);
        }
    }
    lsum += sum0 + sum1;
#pragma unroll
    for (int k = 0; k < 4; ++k) { u32x4 w; w.x = pw[4 * k]; w.y = pw[4 * k + 1]; w.z = pw[4 * k + 2]; w.w = pw[4 * k + 3]; pf[k] = __builtin_bit_cast(bf16x8, w); }
    if (resc) {
#pragma unroll
        for (int d0 = 0; d0 < G::ND; ++d0)
#pragma unroll
            for (int i = 0; i < 16; ++i) O[d0][i] *= al;
    }
    if constexpr (DMA) {
        asm volatile("s_waitcnt vmcnt(4) lgkmcnt(0)\n\ts_barrier" ::: "memory");
    } else {
#pragma unroll
        for (int c = 0; c < G::NKR; ++c) { const int id = tid + 512 * c; *(LAS u32x4*)(sw + (id / G::KCH) * G::KP + (id % G::KCH) * 16) = kreg[c]; }
#pragma unroll
        for (int c = 0; c < G::NVR; ++c) { const int id = tid + 512 * c; *(LAS u32x4*)(sw + G::KB + (id / G::VCH) * G::VP + (id % G::VCH) * 16) = vreg[c]; }
        __syncthreads();
    }
}

template <int KW, int DV, bool WIN, bool DIFF>
__device__ __forceinline__ void attn_unit(LAS unsigned char* lds, const bf16_t* __restrict__ proj, int b, const bf16_t* __restrict__ pk, const bf16_t* __restrict__ pv,
                                          const bf16_t* __restrict__ pkm, const bf16_t* __restrict__ pvm, int kxoff, int kt_lo, int kt_hi,
                                          int qcol, int qi0, float sl2, float m0, float l0, bool started,
                                          bf16_t* __restrict__ Y, int ycol, float lam, const float* __restrict__ subg) {
    constexpr bool DMA = DIFF;
    typedef AttGeo<KW, DV, DMA> G;
    constexpr int ND = G::ND, STG = G::STG;
    static_assert(G::NST * STG <= 131072, "attention stages fit the ring");
    int tid_ = threadIdx.x; asm volatile("" : "+v"(tid_));
    const int tid = tid_, lane = tid & 63, r = lane & 31, h = lane >> 5;
    const int wave = __builtin_amdgcn_readfirstlane(tid >> 6);
    bf16x8 qf[4];
    {
        const bf16_t* qp = proj + (size_t)(b * SEQ + qi0 + r) * PROJ_W + qcol + 8 * h;
#pragma unroll
        for (int ks = 0; ks < 4; ++ks) qf[ks] = *(const bf16x8*)(qp + 16 * ks);
    }
    f32x16 O[ND];
    { float zero = 0.f; asm volatile("" : "+v"(zero));
#pragma unroll
      for (int d0 = 0; d0 < ND; ++d0)
#pragma unroll
        for (int i = 0; i < 16; ++i) O[d0][i] = zero; }
    float mref = m0, lsum = l0;
    const int ntiles = 1 + kt_hi - kt_lo;
    const int qb4 = qi0 + r - 4 * h;
    int koffs[4], voffs[ND], dsrc[4];
    {
        const int q_ = (lane & 15) >> 2, bd = (lane >> 4) & 1, p_ = lane & 3;
        if constexpr (DMA) {
#pragma unroll
            for (int ks = 0; ks < 4; ++ks) koffs[ks] = r * 256 + ((((kxoff >> 3) + 2 * ks + h) ^ (r & 15)) << 4);
#pragma unroll
            for (int d0 = 0; d0 < ND; ++d0) voffs[d0] = G::KB + (4 * h + q_) * 256 + ((4 * (d0 ^ q_) + 2 * bd + (p_ >> 1)) << 4) + (p_ & 1) * 8;
#pragma unroll
            for (int c = 0; c < 2; ++c) { const int row = 4 * (wave * 2 + c) + (lane >> 4), p = lane & 15;
                dsrc[c] = row * KW + ((p ^ (row & 15)) << 3); dsrc[2 + c] = row * DV + ((p ^ ((row & 3) << 2)) << 3); }
        } else {
            const int koff = r * G::KP + (kxoff + 8 * h) * 2, voff = G::KB + (4 * h + q_) * G::VP + (16 * bd + 4 * p_) * 2;
#pragma unroll
            for (int ks = 0; ks < 4; ++ks) koffs[ks] = koff + 32 * ks;
#pragma unroll
            for (int d0 = 0; d0 < ND; ++d0) voffs[d0] = voff + 64 * d0;
#pragma unroll
            for (int c = 0; c < 4; ++c) dsrc[c] = 0;
        }
    }
    bf16x8 pf[4];
#pragma unroll
    for (int k = 0; k < 4; ++k) pf[k] = qf[k];
    int so_prev, so_cur, so_nxt, so_nn;
    if constexpr (DMA) {
        const unsigned w0 = (unsigned)__builtin_amdgcn_readfirstlane((int)(unsigned)(size_t)lds + wave * 2048);
        glds16(pkm + dsrc[0], w0); glds16(pkm + dsrc[1], w0 + 1024); glds16(pvm + dsrc[2], w0 + G::KB); glds16(pvm + dsrc[3], w0 + G::KB + 1024);
        const bf16_t* k1 = pk + (size_t)kt_lo * 64 * KW; const bf16_t* v1 = pv + (size_t)kt_lo * 64 * DV;
        glds16(k1 + dsrc[0], w0 + STG); glds16(k1 + dsrc[1], w0 + STG + 1024); glds16(v1 + dsrc[2], w0 + STG + G::KB); glds16(v1 + dsrc[3], w0 + STG + G::KB + 1024);
        asm volatile("s_waitcnt vmcnt(0)\n\ts_barrier" ::: "memory");
        so_prev = 3 * STG; so_cur = 0; so_nxt = STG; so_nn = 2 * STG;
    } else {
#pragma unroll
        for (int c = 0; c < G::NKR; ++c) { const int id = tid + 512 * c; *(LAS u32x4*)(lds + (id / G::KCH) * G::KP + (id % G::KCH) * 16) = *(const u32x4*)(pkm + id * 8); }
#pragma unroll
        for (int c = 0; c < G::NVR; ++c) { const int id = tid + 512 * c; *(LAS u32x4*)(lds + G::KB + (id / G::VCH) * G::VP + (id % G::VCH) * 16) = *(const u32x4*)(pvm + id * 8); }
        __syncthreads();
        so_prev = 2 * STG; so_cur = 0; so_nxt = STG; so_nn = STG;
    }
#define ATT_ROT() do { if constexpr (DMA) { const int tmp_ = so_prev; so_prev = so_cur; so_cur = so_nxt; so_nxt = so_nn; so_nn = tmp_; } \
                       else { const int tmp_ = so_prev; so_prev = so_cur; so_cur = so_nxt; so_nxt = tmp_; so_nn = so_nxt; } } while (0)
#define ATT_STEP(MODE, HASPV, t) do { const int kt_ = kt_lo + (t) - 1; int ktn_ = kt_ + (DMA ? 2 : 1); ktn_ = (ktn_ < kt_hi) ? ktn_ : kt_hi - 1; \
        att_step<KW, DV, WIN, MODE, HASPV, DMA>(lds + so_cur, lds + so_prev, lds + so_nn, (t) + 1 < ntiles, pk + (size_t)ktn_ * 64 * KW, pv + (size_t)ktn_ * 64 * DV, tid, qf, O, pf, mref, lsum, started, sl2, \
                                               (float)(qb4 - kt_ * 64), koffs, voffs, dsrc); \
        ATT_ROT(); } while (0)
    ATT_STEP(0, false, 0);
    if constexpr (WIN) {
        for (int t = 1; t < ntiles; ++t) ATT_STEP(2, true, t);
    } else {
        const int td = (qi0 >> 6) - kt_lo + 1;
        int t = 1;
        for (; t < td; ++t) ATT_STEP(1, true, t);
        ATT_STEP(2, true, t); ++t;
        for (; t < ntiles; ++t) ATT_STEP(3, true, t);
    }
#undef ATT_STEP
#undef ATT_ROT
    att_pv<KW, DV, DMA>(lds + so_prev, voffs, pf, O);
    if constexpr (DMA) asm volatile("s_waitcnt vmcnt(0)" ::: "memory");
    __syncthreads();
    lsum = half_sum(lsum);
    bf16_t* yrow = Y + (size_t)(b * SEQ + qi0 + r) * 1024 + ycol + 4 * h;
    if constexpr (DIFF) {
        LAS float* xb = (LAS float*)lds + (size_t)(wave >> 1) * (ND * 16 * 64) + lane;
        if (wave & 1) {
            const float i2 = lam / lsum;
#pragma unroll
            for (int d0 = 0; d0 < ND; ++d0)
#pragma unroll
                for (int i = 0; i < 16; ++i) xb[(d0 * 16 + i) * 64] = O[d0][i] * i2;
        }
        __syncthreads();
        if (!(wave & 1)) {
            const float i1 = 1.f / lsum;
            float ssq = 0.f;
#pragma unroll
            for (int d0 = 0; d0 < ND; ++d0)
#pragma unroll
                for (int i = 0; i < 16; ++i) { const float y = O[d0][i] * i1 - xb[(d0 * 16 + i) * 64]; O[d0][i] = y; ssq += y * y; }
            ssq = half_sum(ssq);
            const float rn = (1.0f / sqrtf(ssq * (1.f / DV) + EPS)) * (1.f - LAMBDA_INIT);
#pragma unroll
            for (int d0 = 0; d0 < ND; ++d0)
#pragma unroll
                for (int g4 = 0; g4 < 4; ++g4) {
                    const int d = 32 * d0 + 8 * g4;
                    const f32x4 gv = *(const f32x4*)(subg + d + 4 * h);
                    u32x2 w; w.x = cvtpk(O[d0][4 * g4 + 0] * rn * gv.x, O[d0][4 * g4 + 1] * rn * gv.y); w.y = cvtpk(O[d0][4 * g4 + 2] * rn * gv.z, O[d0][4 * g4 + 3] * rn * gv.w);
                    *(u32x2*)(yrow + d) = w;
                }
        }
        __syncthreads();
    } else {
        const float i1 = 1.f / lsum;
#pragma unroll
        for (int d0 = 0; d0 < ND; ++d0)
#pragma unroll
            for (int g4 = 0; g4 < 4; ++g4) {
                const int d = 32 * d0 + 8 * g4;
                u32x2 w; w.x = cvtpk(O[d0][4 * g4 + 0] * i1, O[d0][4 * g4 + 1] * i1); w.y = cvtpk(O[d0][4 * g4 + 2] * i1, O[d0][4 * g4 + 3] * i1);
                *(u32x2*)(yrow + d) = w;
            }
    }
}

using pg8::Unit;
#define EPI_LOOP_ROWS for (int ai = 0; ai < 2; ++ai) _Pragma("unroll") for (int m = 0; m < 4; ++m)
__device__ __forceinline__ u32x4 pack8(const f32x4& a, const f32x4& b) { u32x4 w; w.x = cvtpk(a[0], a[1]); w.y = cvtpk(a[2], a[3]); w.z = cvtpk(b[0], b[1]); w.w = cvtpk(b[2], b[3]); return w; }
__device__ __forceinline__ void unpack8(const u32x4& w, f32x4& a, f32x4& b) {
    a[0] = __uint_as_float(w.x << 16); a[1] = __uint_as_float(w.x & 0xffff0000u); a[2] = __uint_as_float(w.y << 16); a[3] = __uint_as_float(w.y & 0xffff0000u);
    b[0] = __uint_as_float(w.z << 16); b[1] = __uint_as_float(w.z & 0xffff0000u); b[2] = __uint_as_float(w.w << 16); b[3] = __uint_as_float(w.w & 0xffff0000u); }

struct EpiProj {
    static constexpr bool PERM = true, AFTER_DRAIN = false, HAS_MID = false;
    bf16_t* O; const float* rstd; unsigned char* ws;
    __device__ __forceinline__ void operator()(const f32x4 (&acc)[2][2][4][2], const Unit& u, int wr, int wc, int fr, int fq) const {
        const int pn = u.pn; const bool isq = (pn < 2) || (pn == 6) || (pn == 7), isg = pn >= 9, iskv = !isq && !isg;
        const int cin = wc * 32 + 8 * fq;
        int pcol = 0;
        if (pn < 2) pcol = C_QA + pn * 256; else if (pn == 6 || pn == 7) pcol = C_QB + (pn - 6) * 256; else if (pn >= 13) pcol = C_GB + (pn - 13) * 256; else if (pn >= 9) pcol = C_GA + (pn - 9) * 256;
#pragma unroll
        EPI_LOOP_ROWS { const int row = u.pm * 256 + ai * 128 + wr * 64 + m * 16 + fr; float rs = rstd[row]; if (isq) rs *= QSCALE;
#pragma unroll
            for (int bj = 0; bj < 2; ++bj) { f32x4 a = acc[ai][bj][m][0] * rs, c = acc[ai][bj][m][1] * rs;
                if (isg) {
#pragma unroll
                    for (int j = 0; j < 4; ++j) { a[j] = sigmoidf_(a[j]); c[j] = sigmoidf_(c[j]); } }
                const u32x4 w = pack8(a, c);
                if (!iskv) { *(u32x4*)(O + (size_t)row * PROJ_W + pcol + bj * 128 + cin) = w; }
                else {
                    const bool meta = row >= M_REAL; const int bb = row >> 12, tt = row & 4095, mr = row - M_REAL;
                    if (meta && mr >= 64) continue;
                    bf16_t* dst;
                    if (pn == 8) { const int g = cin >> 6, cc = cin & 63;
                        if (meta) dst = (bf16_t*)(ws + (bj ? WS_VBM : WS_KBM)) + ((size_t)g * 64 + mr) * 64 + cc;
                        else dst = (bf16_t*)(ws + (bj ? WS_VB : WS_KB)) + (((size_t)bb * 2 + g) * 4096 + tt) * 64 + cc;
                    } else { const bool isv = pn >= 4; const int hh = 2 * (pn - (isv ? 4 : 2)) + bj;
                        if (meta) dst = (bf16_t*)(ws + (isv ? WS_VAM : WS_KAM)) + ((size_t)hh * 64 + mr) * 128 + cin;
                        else dst = (bf16_t*)(ws + (isv ? WS_VA : WS_KA)) + (((size_t)bb * 4 + hh) * 4096 + tt) * 128 + cin; }
                    *(u32x4*)dst = w; } } }
        if (pn == 2 || pn == 3) {
            float* kpart = (float*)(ws + WS_STAT) + M_PAD + 2 * M_REAL;
            const bool metat = u.pm * 256 >= M_REAL; const int bb = (u.pm * 256) >> 12;
#pragma unroll
            for (int bj = 0; bj < 2; ++bj) {
                float mx = 0.f;
#pragma unroll
                EPI_LOOP_ROWS { const int row = u.pm * 256 + ai * 128 + wr * 64 + m * 16 + fr; const float rs = rstd[row];
                    const f32x4 a = acc[ai][bj][m][0] * rs, c = acc[ai][bj][m][1] * rs;
                    float pt = (a[0] * a[0] + a[1] * a[1]) + (a[2] * a[2] + a[3] * a[3]) + (c[0] * c[0] + c[1] * c[1]) + (c[2] * c[2] + c[3] * c[3]);
                    pt += __shfl_xor(pt, 16); pt += __shfl_xor(pt, 32);
                    mx = fmaxf(mx, pt); }
                mx = fmaxf(mx, __shfl_xor(mx, 1)); mx = fmaxf(mx, __shfl_xor(mx, 2)); mx = fmaxf(mx, __shfl_xor(mx, 4)); mx = fmaxf(mx, __shfl_xor(mx, 8));
                if (fr == 0 && fq == 0) { const int hh = 2 * (pn - 2) + bj;
                    atomicMax((unsigned*)kpart + (((metat ? 32 + hh : bb * 4 + hh) * 2 + (wc >> 1)) * 2 + (wc & 1)), __float_as_uint(mx)); }
            }
        }
    }
};
struct EpiGate1 {
    static constexpr bool PERM = true, AFTER_DRAIN = false, HAS_MID = false;
    bf16_t* T; const bf16_t* proj;
    __device__ __forceinline__ void operator()(const f32x4 (&acc)[2][2][4][2], const Unit& u, int wr, int wc, int fr, int fq) const {
        const int col0 = u.pn * 256 + wc * 32 + 8 * fq;
#pragma unroll
        for (int ai = 0; ai < 2; ++ai) {
            u32x4 g[4][2];
#pragma unroll
            for (int m = 0; m < 4; ++m)
#pragma unroll
                for (int bj = 0; bj < 2; ++bj) g[m][bj] = *(const u32x4*)(proj + (size_t)(u.pm * 256 + ai * 128 + wr * 64 + m * 16 + fr) * PROJ_W + C_GA + col0 + bj * 128);
#pragma unroll
            for (int m = 0; m < 4; ++m) { const int row = u.pm * 256 + ai * 128 + wr * 64 + m * 16 + fr;
#pragma unroll
                for (int bj = 0; bj < 2; ++bj) { f32x4 ga, gb; unpack8(g[m][bj], ga, gb);
                    *(u32x4*)(T + (size_t)row * D_MODEL + col0 + bj * 128) = pack8(acc[ai][bj][m][0] * ga, acc[ai][bj][m][1] * gb); } }
        }
    }
};
struct EpiGate2 {
    static constexpr bool PERM = true, AFTER_DRAIN = false, HAS_MID = false;
    const bf16_t* T; const bf16_t* proj; bf16_t* Mg;
    __device__ __forceinline__ void operator()(const f32x4 (&acc)[2][2][4][2], const Unit& u, int wr, int wc, int fr, int fq) const {
        const int col0 = u.pn * 256 + wc * 32 + 8 * fq;
#pragma unroll
        for (int ai = 0; ai < 2; ++ai) {
            u32x4 g[4][2], tq[4][2];
#pragma unroll
            for (int m = 0; m < 4; ++m)
#pragma unroll
                for (int bj = 0; bj < 2; ++bj) { const size_t row = (size_t)(u.pm * 256 + ai * 128 + wr * 64 + m * 16 + fr);
                    g[m][bj] = *(const u32x4*)(proj + row * PROJ_W + C_GB + col0 + bj * 128); tq[m][bj] = *(const u32x4*)(T + row * D_MODEL + col0 + bj * 128); }
#pragma unroll
            for (int m = 0; m < 4; ++m) { const int row = u.pm * 256 + ai * 128 + wr * 64 + m * 16 + fr;
#pragma unroll
                for (int bj = 0; bj < 2; ++bj) { f32x4 ga, gb, t0, t1; unpack8(g[m][bj], ga, gb); unpack8(tq[m][bj], t0, t1);
                    *(u32x4*)(Mg + (size_t)row * D_MODEL + col0 + bj * 128) = pack8(t0 + acc[ai][bj][m][0] * ga, t1 + acc[ai][bj][m][1] * gb); } }
        }
    }
};
struct EpiGateFused {
    static constexpr bool PERM = true, AFTER_DRAIN = false, HAS_MID = true;
    const bf16_t* proj; bf16_t* Mg;
    __device__ __forceinline__ void operator()(f32x4 (&acc)[2][2][4][2], const Unit& u, int wr, int wc, int fr, int fq) const {
        const int col0 = u.pn * 256 + wc * 32 + 8 * fq;
        if (u.kh == 0) {
#pragma unroll
            for (int ai = 0; ai < 2; ++ai) {
                u32x4 ga[4][2], gb[4][2];
#pragma unroll
                for (int m = 0; m < 4; ++m)
#pragma unroll
                    for (int bj = 0; bj < 2; ++bj) { const bf16_t* gp = proj + (size_t)(u.pm * 256 + ai * 128 + wr * 64 + m * 16 + fr) * PROJ_W + col0 + bj * 128;
                        ga[m][bj] = *(const u32x4*)(gp + C_GA); gb[m][bj] = *(const u32x4*)(gp + C_GB); }
#pragma unroll
                for (int m = 0; m < 4; ++m)
#pragma unroll
                    for (int bj = 0; bj < 2; ++bj) { f32x4 a0, a1, b0, b1; unpack8(ga[m][bj], a0, a1); unpack8(gb[m][bj], b0, b1);
#pragma unroll
                        for (int j = 0; j < 4; ++j) { acc[ai][bj][m][0][j] *= a0[j] * __builtin_amdgcn_rcpf(fmaxf(b0[j], 1e-30f)); acc[ai][bj][m][1][j] *= a1[j] * __builtin_amdgcn_rcpf(fmaxf(b1[j], 1e-30f)); } }
            }
        } else {
#pragma unroll
            for (int ai = 0; ai < 2; ++ai) {
                u32x4 gb[4][2];
#pragma unroll
                for (int m = 0; m < 4; ++m)
#pragma unroll
                    for (int bj = 0; bj < 2; ++bj) gb[m][bj] = *(const u32x4*)(proj + (size_t)(u.pm * 256 + ai * 128 + wr * 64 + m * 16 + fr) * PROJ_W + C_GB + col0 + bj * 128);
#pragma unroll
                for (int m = 0; m < 4; ++m) { const int row = u.pm * 256 + ai * 128 + wr * 64 + m * 16 + fr;
#pragma unroll
                    for (int bj = 0; bj < 2; ++bj) { f32x4 b0, b1; unpack8(gb[m][bj], b0, b1);
                        *(u32x4*)(Mg + (size_t)row * D_MODEL + col0 + bj * 128) = pack8(acc[ai][bj][m][0] * b0, acc[ai][bj][m][1] * b1); } }
            }
        }
    }
};
struct SplitK2Order {
    pg8::StaticOrder base;
    __device__ bool next(int i, Unit& u) const { if (!base.next(i >> 1, u)) return false; u.kh = i & 1; return true; }
    __device__ __forceinline__ void a_ready(const Unit&) const {}
    __device__ __forceinline__ void done(const Unit&) const {}
};
template <bool BASE_BF16> struct EpiResid {
    static constexpr bool PERM = true, AFTER_DRAIN = false, HAS_MID = false;
    const void* base; bf16_t* ob; float* sumsq;
    __device__ __forceinline__ void operator()(const f32x4 (&acc)[2][2][4][2], const Unit& u, int wr, int wc, int fr, int fq) const {
        const int col0 = u.pn * 256 + wc * 32 + 8 * fq;
#pragma unroll
        for (int ai = 0; ai < 2; ++ai)
#pragma unroll
            for (int mh = 0; mh < 4; mh += 2) {
                f32x4 pre[2][2][2];
#pragma unroll
                for (int mm = 0; mm < 2; ++mm)
#pragma unroll
                    for (int bj = 0; bj < 2; ++bj) { const size_t off = (size_t)(u.pm * 256 + ai * 128 + wr * 64 + (mh + mm) * 16 + fr) * D_MODEL + col0 + bj * 128;
                        if (BASE_BF16) unpack8(*(const u32x4*)((const bf16_t*)base + off), pre[mm][bj][0], pre[mm][bj][1]);
                        else { pre[mm][bj][0] = *(const f32x4*)((const float*)base + off); pre[mm][bj][1] = *(const f32x4*)((const float*)base + off + 4); } }
#pragma unroll
                for (int mm = 0; mm < 2; ++mm) { const int m = mh + mm, row = u.pm * 256 + ai * 128 + wr * 64 + m * 16 + fr; float ss = 0.f;
#pragma unroll
                    for (int bj = 0; bj < 2; ++bj) { const size_t off = (size_t)row * D_MODEL + col0 + bj * 128;
                        const f32x4 a = pre[mm][bj][0] + acc[ai][bj][m][0], c = pre[mm][bj][1] + acc[ai][bj][m][1];
                        *(u32x4*)(ob + off) = pack8(a, c);
                        ss += (a[0] * a[0] + a[1] * a[1]) + (a[2] * a[2] + a[3] * a[3]) + (c[0] * c[0] + c[1] * c[1]) + (c[2] * c[2] + c[3] * c[3]); }
                    ss += __shfl_xor(ss, 16); ss += __shfl_xor(ss, 32);
                    if (fq == 0) atomicAdd(sumsq + row, ss); }
            }
    }
};
struct EpiSwiglu {
    static constexpr bool PERM = true, AFTER_DRAIN = false, HAS_MID = false;
    bf16_t* act; const float* sumsq;
    __device__ __forceinline__ void operator()(const f32x4 (&acc)[2][2][4][2], const Unit& u, int wr, int wc, int fr, int fq) const {
        const int col0 = u.pn * 128 + wc * 32 + 8 * fq;
#pragma unroll
        EPI_LOOP_ROWS { const int row = u.pm * 256 + ai * 128 + wr * 64 + m * 16 + fr; const float rs = __builtin_amdgcn_rsqf(sumsq[row] * (1.f / D_MODEL) + EPS);
            f32x4 o[2];
#pragma unroll
            for (int n = 0; n < 2; ++n)
#pragma unroll
                for (int j = 0; j < 4; ++j) { const float g = acc[ai][0][m][n][j] * rs, up = acc[ai][1][m][n][j] * rs; o[n][j] = g * sigmoidf_(g) * up; }
            *(u32x4*)(act + (size_t)row * D_FF + col0) = pack8(o[0], o[1]); }
    }
};

#define XB_TMO      128
#define XB_XCNT(j)  (256  + 64 * (j))
#define XB_XSUB(j)  (1280 + 64 * (j))
#define XB_XGEN(j)  (2304 + 64 * (j))
#define XB_TOP      3328
#define XB_TOPGEN   3392
#define XCD_BAR_WORDS 3456
#define XB_SPIN_CAP (1u << 18)

__device__ __forceinline__ unsigned xb_ld(unsigned* p)              { return __hip_atomic_load(p, __ATOMIC_RELAXED, __HIP_MEMORY_SCOPE_AGENT); }
__device__ __forceinline__ unsigned xb_add(unsigned* p, unsigned v) { return __hip_atomic_fetch_add(p, v, __ATOMIC_RELAXED, __HIP_MEMORY_SCOPE_AGENT); }
__device__ __forceinline__ unsigned xb_xcc_id() { return (unsigned)__builtin_amdgcn_s_getreg((3 << 11) | 20) & 0xFu; }
#define XB_SPIN(cond, bar) do { unsigned _sp = 0; while (cond) { __builtin_amdgcn_s_sleep(1); \
    if ((++_sp & 255u) == 0u) { if (xb_ld(&(bar)[XB_TMO])) break; if (_sp > XB_SPIN_CAP) { atomicAdd(&(bar)[XB_TMO], 1u); break; } } } } while (0)

struct XcdBarrier {
    unsigned* bar; unsigned x;
    volatile LAS unsigned* st;
};

__device__ __forceinline__ XcdBarrier xcd_barrier_post(unsigned* bar, volatile LAS unsigned* st) {
    XcdBarrier b; b.bar = bar; b.x = xb_xcc_id(); b.st = st;
    if (threadIdx.x == 0) (void)xb_add(&bar[XB_XCNT(b.x)], 1u);
    return b;
}
__device__ __forceinline__ void xcd_barrier_complete(unsigned* bar, unsigned x, unsigned& nloc, unsigned& nx) {
    const unsigned G = gridDim.x * gridDim.y * gridDim.z;
    unsigned sum, cnt, mine, sp = 0u;
    for (;;) {
        sum = 0u; cnt = 0u; mine = 0u;
#pragma unroll
        for (unsigned j = 0; j < 16; ++j) { const unsigned c = xb_ld(&bar[XB_XCNT(j)]); sum += c; cnt += (c > 0u) ? 1u : 0u; mine = (j == x) ? c : mine; }
        if (sum == G) break;
        __builtin_amdgcn_s_sleep(1);
        if ((++sp & 255u) == 0u) { if (xb_ld(&bar[XB_TMO])) break; if (sp > XB_SPIN_CAP) { atomicAdd(&bar[XB_TMO], 1u); break; } }
    }
    nloc = mine > 0u ? mine : 1u; nx = cnt > 0u ? cnt : 1u;
}

__device__ __forceinline__ void xcd_barrier(const XcdBarrier& b) {
    asm volatile("s_waitcnt vmcnt(0)" ::: "memory");
    __syncthreads();
    if (threadIdx.x == 0) {
        unsigned* bar = b.bar;
        __builtin_amdgcn_s_waitcnt(0);
        unsigned nloc = b.st[0], nx = b.st[1];
        if (nloc == 0u) { xcd_barrier_complete(bar, b.x, nloc, nx); b.st[0] = nloc; b.st[1] = nx; }
        const unsigned old = xb_add(&bar[XB_XSUB(b.x)], 1u);
        const unsigned gen = old / nloc;
        if (old + 1u == (gen + 1u) * nloc) {
            __builtin_amdgcn_fence(__ATOMIC_RELEASE, "agent");
            asm volatile("s_waitcnt vmcnt(0)" ::: "memory");
            const unsigned og = xb_add(&bar[XB_TOP], 1u);
            const unsigned tg = og / nx;
            if (og + 1u == (tg + 1u) * nx) xb_add(&bar[XB_TOPGEN], 1u);
            else XB_SPIN(xb_ld(&bar[XB_TOPGEN]) == tg, bar);
            __builtin_amdgcn_fence(__ATOMIC_ACQUIRE, "agent");
            xb_add(&bar[XB_XGEN(b.x)], 1u);
            asm volatile("s_waitcnt vmcnt(0)" ::: "memory");
        } else {
            XB_SPIN(xb_ld(&bar[XB_XGEN(b.x)]) == gen, bar);
            __builtin_amdgcn_fence(__ATOMIC_ACQUIRE, "agent");
            asm volatile("s_waitcnt vmcnt(0)" ::: "memory");
        }
    }
    __syncthreads();
}


__global__ void __launch_bounds__(512) fwd_megakernel(Params p) {
    __shared__ __attribute__((aligned(16))) unsigned char smem[LDS_BYTES];
    cg::grid_group grid = cg::this_grid();
    LAS unsigned char* lds = (LAS unsigned char*)smem;
    const int tid = threadIdx.x, lane = tid & 63, wave = __builtin_amdgcn_readfirstlane(tid >> 6);
    const int G = gridDim.x, bx = blockIdx.x;
    const int vcu = (G % 8 == 0) ? (bx % 8) * (G / 8) + bx / 8 : bx;
    const int gw = bx * 8 + wave, NGW = G * 8;
    unsigned char* ws = p.ws;
    bf16_t* W_in = (bf16_t*)(ws + WS_WIN); bf16_t* W_ba = (bf16_t*)(ws + WS_WBA); bf16_t* W_bb = (bf16_t*)(ws + WS_WBB); bf16_t* W_o = (bf16_t*)(ws + WS_WO);
    bf16_t* W_gu = (bf16_t*)(ws + WS_WGU); bf16_t* W_d = (bf16_t*)(ws + WS_WD);
    float* rstd1 = (float*)(ws + WS_STAT); float* sumsq1 = rstd1 + M_PAD; float* sumsq2 = sumsq1 + M_REAL;
    bf16_t* HB = (bf16_t*)(ws + WS_A); bf16_t* MERGED = (bf16_t*)(ws + WS_KA);
    bf16_t* YA = (bf16_t*)(ws + WS_Y); bf16_t* YB = YA + 512; bf16_t* H1B = YA;
    bf16_t* PROJ = (bf16_t*)(ws + WS_P); bf16_t* ACT = PROJ;

    volatile LAS unsigned* bst = (volatile LAS unsigned*)(lds + 131072 + 64);
    if (tid < 2) bst[tid] = 0u;
    unsigned* barw = (unsigned*)(ws + WS_BAR);
    if (bx == 0) for (int i = tid; i < XCD_BAR_WORDS; i += 512) barw[i] = 0u;
    p0_prologue(p, lds, gw, NGW, wave, lane);
    grid.sync();
    (void)xcd_barrier_post(barw, bst);

    { pg8::Gemm g{HB, W_in, M_PAD, PROJ_N, 1024}; pg8::StaticOrder S; S.init(M_PAD, PROJ_N, G, bx);
      EpiProj E{PROJ, rstd1, ws};
      pg8::gemm_phase<EpiProj, pg8::StaticOrder, true, true>(lds, g, S, E); }
    {
        const int nwg = (M_PAD / 256) * (PROJ_N / 256), rounds = (nwg + G - 1) / G, first_idle = nwg - (rounds - 1) * G, n_idle = G - first_idle;
        if (n_idle <= 0) weight_items(p, lds, W_ITEMS_EARLY, W_ITEMS, gw, NGW, wave, lane);
        else if (bx >= first_idle) weight_items(p, lds, W_ITEMS_EARLY, W_ITEMS, (bx - first_idle) * 8 + wave, n_idle * 8, wave, lane);
    }
    { XcdBarrier xb_; xb_.bar = (unsigned*)(p.ws + WS_BAR); xb_.x = xb_xcc_id(); xb_.st = bst; xcd_barrier(xb_); }

    {
        float lam;
        { const float a = wave_sum(p.lq1[lane] * p.lk1[lane]), c = wave_sum(p.lq2[lane] * p.lk2[lane]); lam = expf(a) - expf(c) + LAMBDA_INIT; }
        for (int u = vcu; u < 1024; u += G) {
            const int g_ = (u & 255) >> 5, r_ = u >> 8, b = 2 * r_ + (g_ >> 2), hh = (g_ + r_) & 3, bh = b * 4 + hh, qblk = u & 31, X = wave & 1;
            const float sl2 = exp2f(-2.f * (float)(hh + 1)) * LOG2E;
            int kt_a = 0, kt_b = 64; float mfix;
            {
                const bf16_t* qp = PROJ + (size_t)(b * SEQ + qblk * 128 + (wave >> 1) * 32 + (lane & 31)) * PROJ_W + C_QA + hh * 128 + X * 64 + 8 * (lane >> 5);
                float q2 = 0.f;
#pragma unroll
                for (int ks = 0; ks < 4; ++ks) { const bf16x8 qv = *(const bf16x8*)(qp + 16 * ks);
#pragma unroll
                    for (int j = 0; j < 8; ++j) { const float f = bf2f((unsigned short)qv[j]); q2 += f * f; } }
                q2 = half_sum(q2);
#pragma unroll
                for (int o = 1; o < 32; o <<= 1) q2 = fmaxf(q2, __shfl_xor(q2, o));
                LAS float* xq = (LAS float*)(lds + 131072 + 256);
                if (lane == 0) xq[wave] = q2;
                __syncthreads();
                float qm = xq[0];
#pragma unroll
                for (int w = 1; w < 8; ++w) qm = fmaxf(qm, xq[w]);
                __syncthreads();
                const float* kpart = (const float*)(ws + WS_STAT) + M_PAD + 2 * M_REAL;
                float km = 0.f;
#pragma unroll
                for (int xx = 0; xx < 2; ++xx) { km = fmaxf(km, kpart[(bh * 2 + xx) * 2] + kpart[(bh * 2 + xx) * 2 + 1]); km = fmaxf(km, kpart[((32 + hh) * 2 + xx) * 2] + kpart[((32 + hh) * 2 + xx) * 2 + 1]); }
                const float Bq = sqrtf(qm * km) * 1.02f;
                mfix = fminf(Bq, 60.f);
                const float D = (70.f + 2.f * Bq) / sl2;
                if (D < 8192.f) { const int Di = (int)D + 1; const int lo = (qblk * 128 - 63 - Di), hi = (qblk * 128 + 127 + Di);
                    kt_a = lo <= 0 ? 0 : (lo + 63) >> 6; kt_b = (hi >> 6) + 1 > 64 ? 64 : (hi >> 6) + 1; }
            }
            attn_unit<128, 128, false, true>(lds, PROJ, b, (const bf16_t*)(ws + WS_KA) + (size_t)bh * 4096 * 128, (const bf16_t*)(ws + WS_VA) + (size_t)bh * 4096 * 128,
                                             (const bf16_t*)(ws + WS_KAM) + hh * 64 * 128, (const bf16_t*)(ws + WS_VAM) + hh * 64 * 128, X * 64, kt_a, kt_b,
                                             C_QA + hh * 128 + X * 64, qblk * 128 + (wave >> 1) * 32, sl2, mfix, 0.f, true, YA, hh * 128, lam, p.subln);
        }
        for (int u = vcu; u < 1024; u += G) {
            const int bg = u >> 6, b = bg >> 1, g = bg & 1, qb = u & 63, head = g * 4 + (wave >> 1);
            const float sl2 = exp2f(-(float)(head + 1)) * LOG2E, sink2 = p.sink[head] * LOG2E;
            const int kt_lo = qb - 2 < 0 ? 0 : qb - 2, kt_hi = qb + 3 > 64 ? 64 : qb + 3;
            attn_unit<64, 64, true, false>(lds, PROJ, b, (const bf16_t*)(ws + WS_KB) + (size_t)bg * 4096 * 64, (const bf16_t*)(ws + WS_VB) + (size_t)bg * 4096 * 64,
                                           (const bf16_t*)(ws + WS_KBM) + g * 64 * 64, (const bf16_t*)(ws + WS_VBM) + g * 64 * 64, 0, kt_lo, kt_hi,
                                           C_QB + head * 64, qb * 64 + (wave & 1) * 32, sl2, sink2, 1.f, true, YB, head * 64, 0.f, nullptr);
        }
    }
    { XcdBarrier xb_; xb_.bar = (unsigned*)(p.ws + WS_BAR); xb_.x = xb_xcc_id(); xb_.st = bst; xcd_barrier(xb_); }

    { pg8::Gemm g{YA, W_ba, M_REAL, 1024, 512, 1024}; SplitK2Order S; S.base.init(M_REAL, 1024, G, bx);
      EpiGateFused E{PROJ, MERGED};
      pg8::gemm_phase<EpiGateFused, SplitK2Order, true, false>(lds, g, S, E); }
    { XcdBarrier xb_; xb_.bar = (unsigned*)(p.ws + WS_BAR); xb_.x = xb_xcc_id(); xb_.st = bst; xcd_barrier(xb_); }

    { pg8::Gemm g{MERGED, W_o, M_REAL, 1024, 1024}; pg8::StaticOrder S; S.init(M_REAL, 1024, G, bx);
      EpiResid<true> E{HB, H1B, sumsq1};
      pg8::gemm_phase<EpiResid<true>, pg8::StaticOrder, true, false>(lds, g, S, E); }
    { XcdBarrier xb_; xb_.bar = (unsigned*)(p.ws + WS_BAR); xb_.x = xb_xcc_id(); xb_.st = bst; xcd_barrier(xb_); }

    { pg8::Gemm g{H1B, W_gu, M_REAL, 2 * D_FF, 1024}; pg8::StaticOrder S; S.init(M_REAL, 2 * D_FF, G, bx);
      EpiSwiglu E{ACT, sumsq1};
      pg8::gemm_phase<EpiSwiglu, pg8::StaticOrder, true, true>(lds, g, S, E); }
    { XcdBarrier xb_; xb_.bar = (unsigned*)(p.ws + WS_BAR); xb_.x = xb_xcc_id(); xb_.st = bst; xcd_barrier(xb_); }

    bf16_t* H2B = HB;
    { pg8::Gemm g{ACT, W_d, M_REAL, 1024, D_FF}; pg8::StaticOrder S; S.init(M_REAL, 1024, G, bx);
      EpiResid<true> E{H1B, H2B, sumsq2};
      pg8::gemm_phase<EpiResid<true>, pg8::StaticOrder, true, false>(lds, g, S, E); }
    { XcdBarrier xb_; xb_.bar = (unsigned*)(p.ws + WS_BAR); xb_.x = xb_xcc_id(); xb_.st = bst; xcd_barrier(xb_); }

    {
        int t6_ = threadIdx.x; asm volatile("" : "+v"(t6_));
        const int lane = t6_ & 63;
        const f32x4* gp = (const f32x4*)p.norm_final + 2 * lane;
        f32x4 gv[2][2];
#pragma unroll
        for (int j = 0; j < 2; ++j) { gv[j][0] = gp[128 * j]; gv[j][1] = gp[128 * j + 1]; }
        for (int m0 = gw; m0 < M_REAL; m0 += 4 * NGW) {
            u32x4 v[4][2]; float rs[4];
#pragma unroll
            for (int q = 0; q < 4; ++q) { const int m = (m0 + q * NGW < M_REAL) ? m0 + q * NGW : m0; const u32x4* hp = (const u32x4*)(H2B + (size_t)m * D_MODEL) + lane;
                rs[q] = sumsq2[m];
#pragma unroll
                for (int j = 0; j < 2; ++j) v[q][j] = hp[64 * j]; }
#pragma unroll
            for (int q = 0; q < 4; ++q) { const int m = m0 + q * NGW; if (m >= M_REAL) break;
                const float r = __builtin_amdgcn_rsqf(rs[q] * (1.f / D_MODEL) + EPS); f32x4* o = (f32x4*)(p.out + (size_t)m * D_MODEL) + 2 * lane;
#pragma unroll
                for (int j = 0; j < 2; ++j) { f32x4 a, c; unpack8(v[q][j], a, c); o[128 * j] = a * r * gv[j][0]; o[128 * j + 1] = c * r * gv[j][1]; } }
        }
    }
}

extern "C" void kernel_launch(void* const* d_in, const int* in_sizes, int n_in, void* d_out, int out_size, void* d_ws, size_t ws_size, hipStream_t stream) {
    static int grid_blocks = 0;
    if (!grid_blocks) {
        if (n_in != 18 || in_sizes[0] != M_REAL * D_MODEL || out_size != M_REAL * D_MODEL || ws_size < WS_END) {
            fprintf(stderr, "kernel_launch: unexpected shapes (n_in %d, in0 %d, out %d, ws %zu); nothing launched\n", n_in, n_in > 0 ? in_sizes[0] : -1, out_size, ws_size); grid_blocks = -1; return; }
        int dev = 0, cus = 0, per_cu = 0;
        hipGetDevice(&dev);
        hipDeviceGetAttribute(&cus, hipDeviceAttributeMultiprocessorCount, dev);
        hipOccupancyMaxActiveBlocksPerMultiprocessor(&per_cu, (const void*)fwd_megakernel, 512, 0);
        if (per_cu < 1) { fprintf(stderr, "kernel_launch: occupancy query says %d blocks/CU\n", per_cu); per_cu = 1; }
        grid_blocks = cus * per_cu;
    }
    if (grid_blocks < 0) return;
    Params p{};
    p.x = (const float*)d_in[0]; p.meta = (const float*)d_in[1]; p.norm_mix = (const float*)d_in[2]; p.w_in = (const float*)d_in[3];
    p.lq1 = (const float*)d_in[4]; p.lk1 = (const float*)d_in[5]; p.lq2 = (const float*)d_in[6]; p.lk2 = (const float*)d_in[7];
    p.subln = (const float*)d_in[8]; p.sink = (const float*)d_in[9]; p.w_ba = (const float*)d_in[10]; p.w_bb = (const float*)d_in[11]; p.w_o = (const float*)d_in[12];
    p.norm_ffn = (const float*)d_in[13]; p.w_g = (const float*)d_in[14]; p.w_u = (const float*)d_in[15]; p.w_d = (const float*)d_in[16]; p.norm_final = (const float*)d_in[17];
    p.out = (float*)d_out; p.ws = (unsigned char*)d_ws;
    void* args[] = {&p};
    hipError_t e = hipLaunchCooperativeKernel((const void*)fwd_megakernel, dim3(grid_blocks), dim3(512), args, 0, stream);
    if (e != hipSuccess) fprintf(stderr, "cooperative launch failed: %s (grid %d)\n", hipGetErrorString(e), grid_blocks);
}
```

```cpp
#include <hip/hip_runtime.h>
#include <hip/hip_cooperative_groups.h>
#include <cstdio>
#include <cstdint>
namespace pg8 {
#define PG8_LAS __attribute__((address_space(3)))
typedef unsigned short bf16_t;
typedef short bf16x8 __attribute__((ext_vector_type(8)));
typedef float f32x4 __attribute__((ext_vector_type(4)));
typedef unsigned u32x4 __attribute__((ext_vector_type(4)));
constexpr int BM = 256, BK = 64, HALF = 128, HTB = HALF * BK * 2  , STAGE_BYTES = 8 * HTB, NXCD = 8, WGM = 8;

__host__ __device__ __forceinline__ int lds_byte(int r, int c) { const int st = (r >> 4) * 2 + (c >> 5), rr = r & 15, cc = c & 31, ob = rr * 64 + cc * 2; return st * 1024 + (ob ^ (((ob >> 9) & 1) << 5)); }
__host__ __device__ __forceinline__ void stage_rc(int b, int& R, int& C) { const int st = b / 1024, sb = b % 1024, swz = sb ^ (((sb >> 9) & 1) << 5); R = (st >> 1) * 16 + swz / 64; C = (st & 1) * 32 + (swz % 64) / 2; }
__host__ __device__ __forceinline__ int perm32(int rho) { const int n = rho >> 4, i = rho & 15; return 8 * (i >> 2) + 4 * n + (i & 3); }

struct Unit { int pm, pn, kh; };
struct Gemm { const bf16_t* A; const bf16_t* Bt; int M, N, K; int ld; };

struct StaticOrder {
    int nM, nN, nwg, G, c;
    __host__ __device__ void init(int M, int N, int G_, int c_) { nM = M / BM; nN = N / BM; nwg = nM * nN; G = G_; c = c_; }
    __host__ __device__ bool next(int i, Unit& u) const {
        const long L = (long)i * G + c; if (L >= nwg) return false;
        int wgid = (int)L; { const int q = nwg / NXCD, r = nwg % NXCD, xcd = wgid % NXCD, off = wgid / NXCD; wgid = (xcd < r ? xcd * (q + 1) : r * (q + 1) + (xcd - r) * q) + off; }
        const int nig = WGM * nN, gid = wgid / nig, fm = gid * WGM, gsz = (nM - fm) < WGM ? (nM - fm) : WGM;
        u.pm = fm + ((wgid % nig) % gsz); u.pn = (wgid % nig) / gsz; u.kh = 0; return true;
    }
    __device__ __forceinline__ void a_ready(const Unit&) const {}
    __device__ __forceinline__ void done(const Unit&) const {}
};

__device__ __forceinline__ unsigned cvt_pk_bf16(float lo, float hi) { unsigned r; asm volatile("v_cvt_pk_bf16_f32 %0, %1, %2" : "=v"(r) : "v"(lo), "v"(hi)); return r; }
template <class Epi, class Sched, bool ALIGN_EPI = false, bool SP2 = false>
__device__ __forceinline__ void gemm_phase(PG8_LAS unsigned char* lds, const Gemm g, const Sched& S, const Epi& E) {
    int tid_ = threadIdx.x; asm volatile("" : "+v"(tid_));
    const int tid = tid_, wid = __builtin_amdgcn_readfirstlane(tid >> 6), lane = tid & 63, wr = wid >> 2, wc = wid & 3, fr = lane & 15, fq = lane >> 4;
    const int K = g.ld ? g.ld : g.K, nt = g.K / BK;
    const size_t khstep = (size_t)g.K * 2;
    unsigned voffA[2], voffB[2];
#pragma unroll
    for (int i = 0; i < 2; ++i) { int R, C; stage_rc(tid * 16 + i * 8192, R, C); const int Rb = Epi::PERM ? ((R & ~31) + perm32(R & 31)) : R;
        voffA[i] = (unsigned)(R * K + C) * 2u; voffB[i] = (unsigned)(Rb * K + C) * 2u; }
    const size_t kstep = (size_t)(BK * 2);
    const size_t hstep = (size_t)HALF * K * 2;
    const size_t tstep = 2 * hstep;
    const unsigned ldsw = (unsigned)wid * 1024u;
    const int aoff = lds_byte(wr * 64 + fr, fq * 8), boff = lds_byte(wc * 32 + fr, fq * 8);
#define PG8_SA(b, h) (((b) * 2 + (h)) * HTB)
#define PG8_SB(b, h) ((4 + (b) * 2 + (h)) * HTB)
#define PG8_STAGE(bufoff, gbase, voff) do { _Pragma("unroll") for (int _i = 0; _i < 2; ++_i) \
        __builtin_amdgcn_global_load_lds((const unsigned*)((const char*)(gbase) + (voff)[_i]), (PG8_LAS unsigned*)(lds + (bufoff) + ldsw + _i * 8192), 16, 0, 0); } while (0)
#define PG8_LDA(dst, b, h) do { _Pragma("unroll") for (int m = 0; m < 4; ++m) _Pragma("unroll") for (int k = 0; k < 2; ++k) dst[m][k] = *(const PG8_LAS bf16x8*)(lds + PG8_SA(b, h) + aoff + m * 2048 + k * 1024); } while (0)
#define PG8_LDB(dst, b, h) do { _Pragma("unroll") for (int n = 0; n < 2; ++n) _Pragma("unroll") for (int k = 0; k < 2; ++k) dst[n][k] = *(const PG8_LAS bf16x8*)(lds + PG8_SB(b, h) + boff + n * 2048 + k * 1024); } while (0)
#define PG8_MMA(ai, bj, At, Bt) do { __builtin_amdgcn_s_setprio(1); _Pragma("unroll") for (int m = 0; m < 4; ++m) _Pragma("unroll") for (int n = 0; n < 2; ++n) _Pragma("unroll") for (int k = 0; k < 2; ++k) \
        acc[ai][bj][m][n] = __builtin_amdgcn_mfma_f32_16x16x32_bf16(Bt[n][k], At[m][k], acc[ai][bj][m][n], 0, 0, 0); __builtin_amdgcn_s_setprio(0); } while (0)
#define PG8_WAIT_V(n) asm volatile("s_waitcnt vmcnt(" #n ")" ::: "memory")
#define PG8_WAIT_L(n) asm volatile("s_waitcnt lgkmcnt(" #n ")" ::: "memory")
#define PG8_BAR __builtin_amdgcn_s_barrier()
#define PG8_SCHED __builtin_amdgcn_sched_barrier(0)
    Unit cur, nxt; int ui = 0;
    if (!S.next(0, cur)) return;
    f32x4 acc[2][2][4][2];
#pragma unroll
    for (int a = 0; a < 2; ++a)
#pragma unroll
        for (int b = 0; b < 2; ++b)
#pragma unroll
            for (int m = 0; m < 4; ++m)
#pragma unroll
                for (int n = 0; n < 2; ++n) acc[a][b][m][n] = (f32x4){0.f, 0.f, 0.f, 0.f};
    bf16x8 At[4][2], B0[2][2], B1[2][2];
    const char* cA = (const char*)g.A + (size_t)cur.pm * tstep + cur.kh * khstep; const char* cB = (const char*)g.Bt + (size_t)cur.pn * tstep + cur.kh * khstep;
    S.a_ready(cur);
    if constexpr (SP2) {
        PG8_STAGE(PG8_SB(0, 0), cB, voffB); PG8_STAGE(PG8_SB(0, 1), cB + hstep, voffB); PG8_STAGE(PG8_SA(0, 0), cA, voffA); PG8_STAGE(PG8_SA(0, 1), cA + hstep, voffA);
        if (wr == 1) PG8_BAR;
        PG8_WAIT_V(2); PG8_BAR;
        PG8_STAGE(PG8_SB(1, 0), cB + kstep, voffB); PG8_STAGE(PG8_SA(1, 0), cA + kstep, voffA); PG8_STAGE(PG8_SB(1, 1), cB + hstep + kstep, voffB);
        PG8_WAIT_V(6); PG8_BAR;
    } else {
        PG8_STAGE(PG8_SB(0, 0), cB, voffB); PG8_STAGE(PG8_SA(0, 0), cA, voffA); PG8_STAGE(PG8_SB(0, 1), cB + hstep, voffB); PG8_STAGE(PG8_SA(0, 1), cA + hstep, voffA);
        if (wr == 1) PG8_BAR;
        PG8_WAIT_V(4); PG8_BAR;
        PG8_STAGE(PG8_SB(1, 0), cB + kstep, voffB); PG8_STAGE(PG8_SA(1, 0), cA + kstep, voffA); PG8_STAGE(PG8_SB(1, 1), cB + hstep + kstep, voffB);
        PG8_WAIT_V(6); PG8_BAR;
    }
    for (;;) {
        const bool has_next = S.next(ui + 1, nxt);
        const char* nA = has_next ? (const char*)g.A + (size_t)nxt.pm * tstep + nxt.kh * khstep : cA; const char* nB = has_next ? (const char*)g.Bt + (size_t)nxt.pn * tstep + nxt.kh * khstep : cB;
        for (int t = 0; t < nt; t += 2) {
            const bool last = (t == nt - 2);
            const char* a1 = cA + (size_t)(t + 1) * kstep;
            const char* a2 = last ? nA : cA + (size_t)(t + 2) * kstep; const char* b2 = last ? nB : cB + (size_t)(t + 2) * kstep;
            const char* a3 = a2 + kstep; const char* b3 = b2 + kstep;
            if (last && has_next) S.a_ready(nxt);
            if constexpr (SP2) {
            PG8_LDB(B0, 0, 0); PG8_LDB(B1, 0, 1); PG8_SCHED; PG8_LDA(At, 0, 0); PG8_STAGE(PG8_SA(1, 1), a1 + hstep, voffA);
            PG8_WAIT_V(8); PG8_WAIT_L(0); PG8_BAR; PG8_MMA(0, 0, At, B0); PG8_MMA(0, 1, At, B1); PG8_BAR; PG8_SCHED;
            PG8_LDA(At, 0, 1); PG8_STAGE(PG8_SB(0, 0), b2, voffB); PG8_STAGE(PG8_SB(0, 1), b2 + hstep, voffB); PG8_STAGE(PG8_SA(0, 0), a2, voffA);
            PG8_WAIT_V(8); PG8_WAIT_L(0); PG8_BAR; PG8_MMA(1, 0, At, B0); PG8_MMA(1, 1, At, B1); PG8_BAR; PG8_SCHED;
            PG8_LDB(B0, 1, 0); PG8_LDB(B1, 1, 1); PG8_SCHED; PG8_LDA(At, 1, 0); PG8_STAGE(PG8_SA(0, 1), a2 + hstep, voffA);
            PG8_WAIT_V(8); PG8_WAIT_L(0); PG8_BAR; PG8_MMA(0, 0, At, B0); PG8_MMA(0, 1, At, B1); PG8_BAR; PG8_SCHED;
            PG8_LDA(At, 1, 1); PG8_STAGE(PG8_SB(1, 0), b3, voffB); PG8_STAGE(PG8_SB(1, 1), b3 + hstep, voffB); PG8_STAGE(PG8_SA(1, 0), a3, voffA);
            PG8_WAIT_V(8); PG8_WAIT_L(0); PG8_BAR; PG8_MMA(1, 0, At, B0); PG8_MMA(1, 1, At, B1); PG8_BAR; PG8_SCHED;
            } else {
            PG8_LDB(B0, 0, 0); PG8_SCHED; PG8_LDA(At, 0, 0); PG8_STAGE(PG8_SA(1, 1), a1 + hstep, voffA);
            PG8_WAIT_L(8); PG8_BAR; PG8_WAIT_L(0); PG8_MMA(0, 0, At, B0); PG8_BAR; PG8_SCHED;
            PG8_LDB(B1, 0, 1); PG8_STAGE(PG8_SB(0, 0), b2, voffB);
            PG8_BAR; PG8_WAIT_L(0); PG8_MMA(0, 1, At, B1); PG8_BAR;
            PG8_LDA(At, 0, 1); PG8_STAGE(PG8_SA(0, 0), a2, voffA);
            PG8_BAR; PG8_WAIT_L(0); PG8_MMA(1, 0, At, B0); PG8_BAR; PG8_SCHED;
            PG8_STAGE(PG8_SB(0, 1), b2 + hstep, voffB);
            PG8_WAIT_V(6); PG8_BAR; PG8_MMA(1, 1, At, B1); PG8_BAR;
            PG8_LDB(B0, 1, 0); PG8_SCHED; PG8_LDA(At, 1, 0); PG8_STAGE(PG8_SA(0, 1), a2 + hstep, voffA);
            PG8_WAIT_L(8); PG8_BAR; PG8_WAIT_L(0); PG8_MMA(0, 0, At, B0); PG8_BAR; PG8_SCHED;
            PG8_LDB(B1, 1, 1); PG8_STAGE(PG8_SB(1, 0), b3, voffB);
            PG8_BAR; PG8_WAIT_L(0); PG8_MMA(0, 1, At, B1); PG8_BAR;
            PG8_LDA(At, 1, 1); PG8_STAGE(PG8_SA(1, 0), a3, voffA);
            PG8_BAR; PG8_WAIT_L(0); PG8_MMA(1, 0, At, B0); PG8_BAR; PG8_SCHED;
            PG8_STAGE(PG8_SB(1, 1), b3 + hstep, voffB);
            PG8_WAIT_V(6); PG8_BAR; PG8_MMA(1, 1, At, B1); PG8_BAR;
            }
        }
        if constexpr (ALIGN_EPI) { if (wr == 0) PG8_BAR; }
        if constexpr (!Epi::AFTER_DRAIN) { E(acc, cur, wr, wc, fr, fq); S.done(cur); }
        if (!has_next) break;
        if (!Epi::HAS_MID || cur.kh != 0) {
#pragma unroll
        for (int a = 0; a < 2; ++a)
#pragma unroll
            for (int b = 0; b < 2; ++b)
#pragma unroll
                for (int m = 0; m < 4; ++m)
#pragma unroll
                    for (int n = 0; n < 2; ++n) acc[a][b][m][n] = (f32x4){0.f, 0.f, 0.f, 0.f};
        }
        cur = nxt; cA = nA; cB = nB; ++ui;
        if constexpr (ALIGN_EPI) { if (wr == 1) PG8_BAR; }
    }
    PG8_WAIT_V(0);
    if constexpr (!ALIGN_EPI) { if (wr == 0) PG8_BAR; }
    PG8_BAR;
    if constexpr (Epi::AFTER_DRAIN) { E.fused(acc, cur, wr, wc, fr, fq, lds, wid, lane); S.done(cur); }
#undef PG8_SA
#undef PG8_SB
#undef PG8_STAGE
#undef PG8_LDA
#undef PG8_LDB
#undef PG8_MMA
#undef PG8_WAIT_V
#undef PG8_WAIT_L
#undef PG8_BAR
#undef PG8_SCHED
}
}

namespace cg = cooperative_groups;
#define LAS __attribute__((address_space(3)))
typedef unsigned short bf16_t;
typedef short bf16x8 __attribute__((ext_vector_type(8)));
typedef short s16x4 __attribute__((ext_vector_type(4)));
typedef float f32x4 __attribute__((ext_vector_type(4)));
typedef float f32x16 __attribute__((ext_vector_type(16)));
typedef unsigned u32x4 __attribute__((ext_vector_type(4)));
typedef unsigned u32x2 __attribute__((ext_vector_type(2)));

constexpr int D_MODEL = 1024, BATCH = 8, SEQ = 4096, N_META = 16;
constexpr int M_REAL = BATCH * SEQ;
constexpr int M_PAD = M_REAL + 256;
constexpr int PROJ_W = 3072, D_FF = 2816;
constexpr int PROJ_N = 4352;
constexpr int C_QA = 0, C_QB = 512, C_GA = 1024, C_GB = 2048;
constexpr float EPS = 1e-6f, LOG2E = 1.4426950408889634f, QSCALE = 0.125f * LOG2E;
constexpr float LAMBDA_INIT = 0.2f;

constexpr size_t MiB = 1u << 20;
constexpr size_t WS_WIN = 0, WS_WBA = 9 * MiB, WS_WBB = 10 * MiB, WS_WO = 11 * MiB, WS_WGU = 13 * MiB, WS_WD = 24 * MiB;
constexpr size_t WS_BAR = 31 * MiB;
constexpr size_t WS_STAT = 30 * MiB;
constexpr size_t WS_A = 32 * MiB;
constexpr size_t WS_Y = 97 * MiB;
constexpr size_t WS_P = 161 * MiB;
constexpr size_t WS_KA = 355 * MiB, WS_VA = 387 * MiB, WS_KB = 419 * MiB, WS_VB = 427 * MiB;
constexpr size_t WS_KAM = 435 * MiB, WS_VAM = WS_KAM + 65536, WS_KBM = WS_VAM + 65536, WS_VBM = WS_KBM + 16384;
constexpr size_t WS_END = 436 * MiB;
static_assert(WS_P + (size_t)M_PAD * PROJ_W * 2 <= WS_KA && WS_P + (size_t)M_REAL * D_FF * 2 <= WS_KA, "ws map");

constexpr int LDS_BYTES = 131072 + 8192;

struct Params {
    const float* x; const float* meta; const float* norm_mix; const float* w_in;
    const float* lq1; const float* lk1; const float* lq2; const float* lk2;
    const float* subln; const float* sink; const float* w_ba; const float* w_bb; const float* w_o;
    const float* norm_ffn; const float* w_g; const float* w_u; const float* w_d; const float* norm_final;
    float* out; unsigned char* ws;
};

__device__ __forceinline__ float bf2f(unsigned short v) { return __uint_as_float((unsigned)v << 16); }
typedef float f32x2_t __attribute__((ext_vector_type(2))); typedef __bf16 bf16x2_t __attribute__((ext_vector_type(2)));
__device__ __forceinline__ unsigned cvtpk(float lo, float hi) { f32x2_t v = {lo, hi}; bf16x2_t b = __builtin_convertvector(v, bf16x2_t); return __builtin_bit_cast(unsigned, b); }
__device__ __forceinline__ float wave_sum(float v) {
#pragma unroll
    for (int o = 1; o < 64; o <<= 1) v += __shfl_xor(v, o);
    return v;
}
__device__ __forceinline__ float half_max(float v) { auto rr = __builtin_amdgcn_permlane32_swap(__float_as_uint(v), __float_as_uint(v), false, false); return fmaxf(__uint_as_float(rr[0]), __uint_as_float(rr[1])); }
__device__ __forceinline__ float half_sum(float v) { auto rr = __builtin_amdgcn_permlane32_swap(__float_as_uint(v), __float_as_uint(v), false, false); return __uint_as_float(rr[0]) + __uint_as_float(rr[1]); }
__device__ __forceinline__ float sigmoidf_(float v) { return __builtin_amdgcn_rcpf(1.f + __builtin_amdgcn_exp2f(-v * LOG2E)); }

__device__ __forceinline__ void transpose_item(const float* __restrict__ W, int K, int N, const float* __restrict__ gain, bf16_t* __restrict__ WT,
                                               int dst_row0, int k0, int n0, LAS float* scr, int lane, int ldw = 0, int kdst = 0) {
    if (ldw == 0) ldw = K;
    float wv[32];
#pragma unroll
    for (int i = 0; i < 32; ++i) wv[i] = W[(size_t)(k0 + 2 * i + (lane >> 5)) * N + n0 + (lane & 31)];
#pragma unroll
    for (int i = 0; i < 32; ++i) { const int kk = 2 * i + (lane >> 5); const float g = gain ? gain[k0 + kk] : 1.f; scr[kk * 33 + (lane & 31)] = wv[i] * g; }
    asm volatile("s_waitcnt lgkmcnt(0)" ::: "memory");
    const int c = lane & 7;
#pragma unroll
    for (int j = 0; j < 4; ++j) { const int n = (lane >> 3) + 8 * j; const LAS float* s = scr + (8 * c) * 33 + n;
        u32x4 o; o.x = cvtpk(s[0 * 33], s[1 * 33]); o.y = cvtpk(s[2 * 33], s[3 * 33]); o.z = cvtpk(s[4 * 33], s[5 * 33]); o.w = cvtpk(s[6 * 33], s[7 * 33]);
        *(u32x4*)(WT + (size_t)(dst_row0 + n) * ldw + kdst + k0 + 8 * c) = o; }
    asm volatile("s_waitcnt lgkmcnt(0)" ::: "memory");
}

constexpr int W_I_IN = 16 * 136, W_I_BA = 8 * 32, W_I_O = 16 * 32, W_I_G = 16 * 88, W_I_D = 44 * 32;
constexpr int W_ITEMS_EARLY = W_I_IN + 2 * W_I_BA + W_I_O, W_ITEMS = W_ITEMS_EARLY + 2 * W_I_G + W_I_D;
__device__ __forceinline__ void weight_items(const Params& p, LAS unsigned char* lds, int first, int last, int gw, int NGW, int wave, int lane);
__device__ __forceinline__ void p0_prologue_rows(const Params& p, int gw, int NGW, int lane);
__device__ __forceinline__ void p0_prologue(const Params& p, LAS unsigned char* lds, int gw, int NGW, int wave, int lane) {
    p0_prologue_rows(p, gw, NGW, lane);
    weight_items(p, lds, 0, W_ITEMS_EARLY, gw, NGW, wave, lane);
}
__device__ __forceinline__ void weight_items(const Params& p, LAS unsigned char* lds, int first, int last, int gw, int NGW, int wave, int lane) {
    unsigned char* ws = p.ws;
    LAS float* scr = (LAS float*)(lds + wave * 16384);
    constexpr int I_IN = W_I_IN, I_BA = W_I_BA, I_O = W_I_O, I_G = W_I_G;
    for (int it = first + gw; it < last; it += NGW) {
        int r = it;
        if (r < I_IN) { const int kb = r / 136, nb = r % 136; transpose_item(p.w_in, 1024, PROJ_N, p.norm_mix, (bf16_t*)(ws + WS_WIN), nb * 32, kb * 64, nb * 32, scr, lane); continue; } r -= I_IN;
        if (r < I_BA) { const int kb = r / 32, nb = r % 32; transpose_item(p.w_ba, 512, 1024, nullptr, (bf16_t*)(ws + WS_WBA), nb * 32, kb * 64, nb * 32, scr, lane, 1024, 0); continue; } r -= I_BA;
        if (r < I_BA) { const int kb = r / 32, nb = r % 32; transpose_item(p.w_bb, 512, 1024, nullptr, (bf16_t*)(ws + WS_WBA), nb * 32, kb * 64, nb * 32, scr, lane, 1024, 512); continue; } r -= I_BA;
        if (r < I_O) { const int kb = r / 32, nb = r % 32; transpose_item(p.w_o, 1024, 1024, nullptr, (bf16_t*)(ws + WS_WO), nb * 32, kb * 64, nb * 32, scr, lane); continue; } r -= I_O;
        if (r < 2 * I_G) { const int up = r >= I_G; if (up) r -= I_G; const int kb = r / 88, nb = r % 88, n0 = nb * 32;
            transpose_item(up ? p.w_u : p.w_g, 1024, D_FF, p.norm_ffn, (bf16_t*)(ws + WS_WGU), 256 * (n0 >> 7) + (n0 & 127) + (up ? 128 : 0), kb * 64, n0, scr, lane); continue; } r -= 2 * I_G;
        { const int kb = r / 32, nb = r % 32; transpose_item(p.w_d, D_FF, 1024, nullptr, (bf16_t*)(ws + WS_WD), nb * 32, kb * 64, nb * 32, scr, lane); }
    }
}
__device__ __forceinline__ void p0_prologue_rows(const Params& p, int gw, int NGW, int lane) {
    unsigned char* ws = p.ws;
    bf16_t* HB = (bf16_t*)(ws + WS_A); float* rstd1 = (float*)(ws + WS_STAT);
    for (int m0 = gw; m0 < M_REAL; m0 += 4 * NGW) {
        f32x4 v[4][4];
#pragma unroll
        for (int q = 0; q < 4; ++q) { const int m = m0 + q * NGW; const f32x4* xr = (const f32x4*)(p.x + (size_t)(m < M_REAL ? m : m0) * D_MODEL) + lane;
#pragma unroll
            for (int j = 0; j < 4; ++j) v[q][j] = xr[64 * j]; }
#pragma unroll
        for (int q = 0; q < 4; ++q) { const int m = m0 + q * NGW; if (m >= M_REAL) break;
            float s = 0.f;
#pragma unroll
            for (int j = 0; j < 4; ++j) s += (v[q][j].x * v[q][j].x + v[q][j].y * v[q][j].y) + (v[q][j].z * v[q][j].z + v[q][j].w * v[q][j].w);
            s = wave_sum(s);
            if (lane == 0) rstd1[m] = __builtin_amdgcn_rsqf(s * (1.f / D_MODEL) + EPS);
            unsigned long long* o8 = (unsigned long long*)(HB + (size_t)m * D_MODEL) + lane;
#pragma unroll
            for (int j = 0; j < 4; ++j) o8[64 * j] = (unsigned long long)cvtpk(v[q][j].x, v[q][j].y) | ((unsigned long long)cvtpk(v[q][j].z, v[q][j].w) << 32); }
    }
    for (int m = M_REAL + gw; m < M_PAD; m += NGW) {
        unsigned long long* o8 = (unsigned long long*)(HB + (size_t)m * D_MODEL) + lane;
        if (m >= M_REAL + N_META) {
#pragma unroll
            for (int j = 0; j < 4; ++j) o8[64 * j] = 0ull;
            if (lane == 0) rstd1[m] = 0.f;
            continue;
        }
        const f32x4* xr = (const f32x4*)(p.meta + (size_t)(m - M_REAL) * D_MODEL) + lane;
        f32x4 v[4]; float s = 0.f;
#pragma unroll
        for (int j = 0; j < 4; ++j) { v[j] = xr[64 * j]; s += (v[j].x * v[j].x + v[j].y * v[j].y) + (v[j].z * v[j].z + v[j].w * v[j].w); }
        s = wave_sum(s);
        if (lane == 0) rstd1[m] = __builtin_amdgcn_rsqf(s * (1.f / D_MODEL) + EPS);
#pragma unroll
        for (int j = 0; j < 4; ++j) o8[64 * j] = (unsigned long long)cvtpk(v[j].x, v[j].y) | ((unsigned long long)cvtpk(v[j].z, v[j].w) << 32);
    }
    float* ss = (float*)(ws + WS_STAT) + M_PAD;
    for (int i = gw * 64 + lane; i < 2 * M_REAL + 256; i += NGW * 64) ss[i] = 0.f;
}

template <int KW, int DV, bool DMA> struct AttGeo {
    static constexpr int KP = DMA ? KW * 2 : KW * 2 + 16, VP = DMA ? DV * 2 : DV * 2 + 64, KB = 64 * KP, STG = KB + 64 * VP, NST = DMA ? 4 : 3;
    static constexpr int KCH = KW / 8, VCH = DV / 8, ND = DV / 32, NKR = KW / 64, NVR = DV / 64;
};
__device__ __forceinline__ void glds16(const void* gsrc, unsigned lds_dst) { unsigned keep;
    asm volatile("s_mov_b32 %0, m0\n\ts_mov_b32 m0, %2\n\ts_nop 0\n\tglobal_load_lds_dwordx4 %1, off\n\ts_mov_b32 m0, %0" : "=&s"(keep) : "v"(gsrc), "s"(lds_dst) : "memory"); }
template <int KW, int DV, bool DMA>
__device__ __forceinline__ void att_pv(LAS unsigned char* sv, const int (&voffs)[DV / 32], const bf16x8 (&pf)[4], f32x16 (&O)[DV / 32]) {
    typedef AttGeo<KW, DV, DMA> G;
#pragma unroll
    for (int ks = 0; ks < 4; ++ks)
#pragma unroll
        for (int d0 = 0; d0 < G::ND; ++d0) {
            const s16x4 lo = __builtin_bit_cast(s16x4, __builtin_amdgcn_ds_read_tr16_b64_v4i16((LAS s16x4*)(sv + voffs[d0] + (16 * ks) * G::VP)));
            const s16x4 hi = __builtin_bit_cast(s16x4, __builtin_amdgcn_ds_read_tr16_b64_v4i16((LAS s16x4*)(sv + voffs[d0] + (16 * ks + 8) * G::VP)));
            const bf16x8 vf = __builtin_shufflevector(lo, hi, 0, 1, 2, 3, 4, 5, 6, 7);
            O[d0] = __builtin_amdgcn_mfma_f32_32x32x16_bf16(vf, pf[ks], O[d0], 0, 0, 0);
        }
}
template <int KW, int DV, bool WIN, int MODE, bool HAS_PV, bool DMA>
__device__ __forceinline__ void att_step(LAS unsigned char* sk, LAS unsigned char* sv, LAS unsigned char* sw, bool do_load, const bf16_t* __restrict__ gk, const bf16_t* __restrict__ gv, int tid,
                                         const bf16x8 (&qf)[4], f32x16 (&O)[DV / 32], bf16x8 (&pf)[4], float& mref, float& lsum, bool& started,
                                         float sl2, float dbase, const int (&koffs)[4], const int (&voffs)[DV / 32], const int (&dsrc)[4]) {
    typedef AttGeo<KW, DV, DMA> G;
    constexpr float NEG = -1e30f, THR = 32.f;
    u32x4 kreg[G::NKR], vreg[G::NVR];
    if constexpr (DMA) {
        const unsigned wdst = (unsigned)__builtin_amdgcn_readfirstlane((int)(unsigned)(size_t)sw + (tid >> 6) * 2048);
        glds16(gk + dsrc[0], wdst); glds16(gk + dsrc[1], wdst + 1024);
        glds16(gv + dsrc[2], wdst + G::KB); glds16(gv + dsrc[3], wdst + G::KB + 1024);
    } else {
#pragma unroll
        for (int c = 0; c < G::NKR; ++c) kreg[c] = *(const u32x4*)(gk + (tid + 512 * c) * 8);
#pragma unroll
        for (int c = 0; c < G::NVR; ++c) vreg[c] = *(const u32x4*)(gv + (tid + 512 * c) * 8);
    }
    f32x16 S[2];
    {
        float c0 = -mref;
        if (MODE == 1) c0 = fmaf(-sl2, dbase, -mref);
        if (MODE == 3) c0 = fmaf(sl2, dbase, -mref);
        bf16x8 kf[8];
#pragma unroll
        for (int ks = 0; ks < 4; ++ks)
#pragma unroll
            for (int blk = 0; blk < 2; ++blk) kf[2 * ks + blk] = *(const LAS bf16x8*)(sk + koffs[ks] + blk * 32 * G::KP);
        asm volatile("" : "+v"(c0));
        f32x16 Ct;
#pragma unroll
        for (int i = 0; i < 16; ++i) Ct[i] = c0;
        __builtin_amdgcn_sched_barrier(0);
        S[0] = __builtin_amdgcn_mfma_f32_32x32x16_bf16(kf[0], qf[0], Ct, 0, 0, 0);
        S[1] = __builtin_amdgcn_mfma_f32_32x32x16_bf16(kf[1], qf[0], Ct, 0, 0, 0);
#pragma unroll
        for (int ks = 1; ks < 4; ++ks)
#pragma unroll
            for (int blk = 0; blk < 2; ++blk) S[blk] = __builtin_amdgcn_mfma_f32_32x32x16_bf16(kf[2 * ks + blk], qf[ks], S[blk], 0, 0, 0);
    }
    if (MODE == 0) {
#pragma unroll
        for (int i = 0; i < 16; ++i) { if (i >= 8) S[0][i] = NEG; S[1][i] = NEG; }
    } else if (MODE == 2) {
#pragma unroll
        for (int blk = 0; blk < 2; ++blk)
#pragma unroll
            for (int i = 0; i < 16; ++i) {
                const float d = fabsf(dbase - (float)(32 * blk + (i & 3) + 8 * (i >> 2)));
                float v = fmaf(-sl2, d, S[blk][i]);
                if (WIN) v = (d <= 128.f) ? v : NEG;
                S[blk][i] = v;
            }
    } else {
#pragma unroll
        for (int blk = 0; blk < 2; ++blk)
#pragma unroll
            for (int i = 0; i < 16; ++i) { S[blk][i] = fmaf((MODE == 1) ? sl2 : -sl2, (float)(32 * blk + (i & 3) + 8 * (i >> 2)), S[blk][i]); asm volatile("" : "+v"(S[blk][i])); }
    }
    bool resc = false; float al = 1.f;
    if constexpr (!DMA) {
    float rm = fmaxf(fmaxf(S[0][0], S[0][1]), S[1][0]);
#pragma unroll
    for (int i = 2; i < 16; i += 2) rm = fmaxf(fmaxf(rm, S[0][i]), S[0][i + 1]);
    rm = fmaxf(rm, S[1][1]);
#pragma unroll
    for (int i = 2; i < 16; i += 2) rm = fmaxf(fmaxf(rm, S[1][i]), S[1][i + 1]);
    rm = half_max(rm);
    if (!started || __any(rm > THR)) {
        const float dl = !started ? rm : fmaxf(rm, 0.f);
        mref += dl;
#pragma unroll
        for (int blk = 0; blk < 2; ++blk)
#pragma unroll
            for (int i = 0; i < 16; ++i) S[blk][i] -= dl;
        al = started ? __builtin_amdgcn_exp2f(-dl) : 1.f;
        lsum *= al;
        resc = true;
    }
    }
    started = true;
    __builtin_amdgcn_sched_barrier(0);
    unsigned pw[16];
    float sum0 = 0.f, sum1 = 0.f;
    if (HAS_PV) {
        constexpr int NM = 4 * G::ND, EPG = 32 / NM, PD = 4;
        bf16x8 vfr[NM];
#define ATT_VRD(m) do { const int ks_ = (m) / G::ND, d0_ = (m) % G::ND; \
            const s16x4 lo_ = __builtin_bit_cast(s16x4, __builtin_amdgcn_ds_read_tr16_b64_v4i16((LAS s16x4*)(sv + voffs[d0_] + (16 * ks_) * G::VP))); \
            const s16x4 hi_ = __builtin_bit_cast(s16x4, __builtin_amdgcn_ds_read_tr16_b64_v4i16((LAS s16x4*)(sv + voffs[d0_] + (16 * ks_ + 8) * G::VP))); \
            vfr[m] = __builtin_shufflevector(lo_, hi_, 0, 1, 2, 3, 4, 5, 6, 7); } while (0)
#pragma unroll
        for (int m = 0; m < PD; ++m) ATT_VRD(m);
        __builtin_amdgcn_sched_barrier(0);
#pragma unroll
        for (int m = 0; m < NM; ++m) {
            if (m + PD < NM) ATT_VRD(m + PD);
            O[m % G::ND] = __builtin_amdgcn_mfma_f32_32x32x16_bf16(vfr[m], pf[m / G::ND], O[m % G::ND], 0, 0, 0);
#pragma unroll
            for (int e = 0; e < EPG; e += 2) {
                const int idx = m * EPG + e, blk = idx >> 4, i = idx & 15;
                const float p0 = __builtin_amdgcn_exp2f(S[blk][i]), p1 = __builtin_amdgcn_exp2f(S[blk][i + 1]);
                sum0 += p0; sum1 += p1;
                pw[idx >> 1] = cvtpk(p0, p1);
                asm volatile("" : "+v"(pw[idx >> 1]), "+v"(sum0), "+v"(sum1));
            }
            __builtin_amdgcn_sched_barrier(0);
        }
#undef ATT_VRD
    } else {
#pragma unroll
        for (int idx = 0; idx < 32; idx += 2) {
            const int blk = idx >> 4, i = idx & 15;
            const float p0 = __builtin_amdgcn_exp2f(S[blk][i]), p1 = __builtin_amdgcn_exp2f(S[blk][i + 1]);
            sum0 += p0; sum1 += p1;
            pw[idx >> 1] = cvtpk(p0, p1);
        }
    }
    lsum += sum0 + sum1;
#pragma unroll
    for (int k = 0; k < 4; ++k) { u32x4 w; w.x = pw[4 * k]; w.y = pw[4 * k + 1]; w.z = pw[4 * k + 2]; w.w = pw[4 * k + 3]; pf[k] = __builtin_bit_cast(bf16x8, w); }
    if (resc) {
#pragma unroll
        for (int d0 = 0; d0 < G::ND; ++d0)
#pragma unroll
            for (int i = 0; i < 16; ++i) O[d0][i] *= al;
    }
    if constexpr (DMA) {
        asm volatile("s_waitcnt vmcnt(4) lgkmcnt(0)\n\ts_barrier" ::: "memory");
    } else {
#pragma unroll
        for (int c = 0; c < G::NKR; ++c) { const int id = tid + 512 * c; *(LAS u32x4*)(sw + (id / G::KCH) * G::KP + (id % G::KCH) * 16) = kreg[c]; }
#pragma unroll
        for (int c = 0; c < G::NVR; ++c) { const int id = tid + 512 * c; *(LAS u32x4*)(sw + G::KB + (id / G::VCH) * G::VP + (id % G::VCH) * 16) = vreg[c]; }
        __syncthreads();
    }
}

template <int KW, int DV, bool WIN, bool DIFF>
__device__ __forceinline__ void attn_unit(LAS unsigned char* lds, const bf16_t* __restrict__ proj, int b, const bf16_t* __restrict__ pk, const bf16_t* __restrict__ pv,
                                          const bf16_t* __restrict__ pkm, const bf16_t* __restrict__ pvm, int kxoff, int kt_lo, int kt_hi,
                                          int qcol, int qi0, float sl2, float m0, float l0, bool started,
                                          bf16_t* __restrict__ Y, int ycol, float lam, const float* __restrict__ subg) {
    constexpr bool DMA = DIFF;
    typedef AttGeo<KW, DV, DMA> G;
    constexpr int ND = G::ND, STG = G::STG;
    static_assert(G::NST * STG <= 131072, "attention stages fit the ring");
    int tid_ = threadIdx.x; asm volatile("" : "+v"(tid_));
    const int tid = tid_, lane = tid & 63, r = lane & 31, h = lane >> 5;
    const int wave = __builtin_amdgcn_readfirstlane(tid >> 6);
    bf16x8 qf[4];
    {
        const bf16_t* qp = proj + (size_t)(b * SEQ + qi0 + r) * PROJ_W + qcol + 8 * h;
#pragma unroll
        for (int ks = 0; ks < 4; ++ks) qf[ks] = *(const bf16x8*)(qp + 16 * ks);
    }
    f32x16 O[ND];
    { float zero = 0.f; asm volatile("" : "+v"(zero));
#pragma unroll
      for (int d0 = 0; d0 < ND; ++d0)
#pragma unroll
        for (int i = 0; i < 16; ++i) O[d0][i] = zero; }
    float mref = m0, lsum = l0;
    const int ntiles = 1 + kt_hi - kt_lo;
    const int qb4 = qi0 + r - 4 * h;
    int koffs[4], voffs[ND], dsrc[4];
    {
        const int q_ = (lane & 15) >> 2, bd = (lane >> 4) & 1, p_ = lane & 3;
        if constexpr (DMA) {
#pragma unroll
            for (int ks = 0; ks < 4; ++ks) koffs[ks] = r * 256 + ((((kxoff >> 3) + 2 * ks + h) ^ (r & 15)) << 4);
#pragma unroll
            for (int d0 = 0; d0 < ND; ++d0) voffs[d0] = G::KB + (4 * h + q_) * 256 + ((4 * (d0 ^ q_) + 2 * bd + (p_ >> 1)) << 4) + (p_ & 1) * 8;
#pragma unroll
            for (int c = 0; c < 2; ++c) { const int row = 4 * (wave * 2 + c) + (lane >> 4), p = lane & 15;
                dsrc[c] = row * KW + ((p ^ (row & 15)) << 3); dsrc[2 + c] = row * DV + ((p ^ ((row & 3) << 2)) << 3); }
        } else {
            const int koff = r * G::KP + (kxoff + 8 * h) * 2, voff = G::KB + (4 * h + q_) * G::VP + (16 * bd + 4 * p_) * 2;
#pragma unroll
            for (int ks = 0; ks < 4; ++ks) koffs[ks] = koff + 32 * ks;
#pragma unroll
            for (int d0 = 0; d0 < ND; ++d0) voffs[d0] = voff + 64 * d0;
#pragma unroll
            for (int c = 0; c < 4; ++c) dsrc[c] = 0;
        }
    }
    bf16x8 pf[4];
#pragma unroll
    for (int k = 0; k < 4; ++k) pf[k] = qf[k];
    int so_prev, so_cur, so_nxt, so_nn;
    if constexpr (DMA) {
        const unsigned w0 = (unsigned)__builtin_amdgcn_readfirstlane((int)(unsigned)(size_t)lds + wave * 2048);
        glds16(pkm + dsrc[0], w0); glds16(pkm + dsrc[1], w0 + 1024); glds16(pvm + dsrc[2], w0 + G::KB); glds16(pvm + dsrc[3], w0 + G::KB + 1024);
        const bf16_t* k1 = pk + (size_t)kt_lo * 64 * KW; const bf16_t* v1 = pv + (size_t)kt_lo * 64 * DV;
        glds16(k1 + dsrc[0], w0 + STG); glds16(k1 + dsrc[1], w0 + STG + 1024); glds16(v1 + dsrc[2], w0 + STG + G::KB); glds16(v1 + dsrc[3], w0 + STG + G::KB + 1024);
        asm volatile("s_waitcnt vmcnt(0)\n\ts_barrier" ::: "memory");
        so_prev = 3 * STG; so_cur = 0; so_nxt = STG; so_nn = 2 * STG;
    } else {
#pragma unroll
        for (int c = 0; c < G::NKR; ++c) { const int id = tid + 512 * c; *(LAS u32x4*)(lds + (id / G::KCH) * G::KP + (id % G::KCH) * 16) = *(const u32x4*)(pkm + id * 8); }
#pragma unroll
        for (int c = 0; c < G::NVR; ++c) { const int id = tid + 512 * c; *(LAS u32x4*)(lds + G::KB + (id / G::VCH) * G::VP + (id % G::VCH) * 16) = *(const u32x4*)(pvm + id * 8); }
        __syncthreads();
        so_prev = 2 * STG; so_cur = 0; so_nxt = STG; so_nn = STG;
    }
#define ATT_ROT() do { if constexpr (DMA) { const int tmp_ = so_prev; so_prev = so_cur; so_cur = so_nxt; so_nxt = so_nn; so_nn = tmp_; } \
                       else { const int tmp_ = so_prev; so_prev = so_cur; so_cur = so_nxt; so_nxt = tmp_; so_nn = so_nxt; } } while (0)
#define ATT_STEP(MODE, HASPV, t) do { const int kt_ = kt_lo + (t) - 1; int ktn_ = kt_ + (DMA ? 2 : 1); ktn_ = (ktn_ < kt_hi) ? ktn_ : kt_hi - 1; \
        att_step<KW, DV, WIN, MODE, HASPV, DMA>(lds + so_cur, lds + so_prev, lds + so_nn, (t) + 1 < ntiles, pk + (size_t)ktn_ * 64 * KW, pv + (size_t)ktn_ * 64 * DV, tid, qf, O, pf, mref, lsum, started, sl2, \
                                               (float)(qb4 - kt_ * 64), koffs, voffs, dsrc); \
        ATT_ROT(); } while (0)
    ATT_STEP(0, false, 0);
    if constexpr (WIN) {
        const int qbk = qi0 >> 6;
        for (int t = 1; t < ntiles; ++t) { const int ktt = kt_lo + t - 1;
            if (ktt == qbk - 1) ATT_STEP(1, true, t); else if (ktt == qbk + 1) ATT_STEP(3, true, t); else ATT_STEP(2, true, t); }
    } else {
        const int td = (qi0 >> 6) - kt_lo + 1;
        int t = 1;
        for (; t < td; ++t) ATT_STEP(1, true, t);
        ATT_STEP(2, true, t); ++t;
        for (; t < ntiles; ++t) ATT_STEP(3, true, t);
    }
#undef ATT_STEP
#undef ATT_ROT
    att_pv<KW, DV, DMA>(lds + so_prev, voffs, pf, O);
    if constexpr (DMA) asm volatile("s_waitcnt vmcnt(0)" ::: "memory");
    __syncthreads();
    lsum = half_sum(lsum);
    bf16_t* yrow = Y + (size_t)(b * SEQ + qi0 + r) * 1024 + ycol + 4 * h;
    if constexpr (DIFF) {
        LAS float* xb = (LAS float*)lds + (size_t)(wave >> 1) * (ND * 16 * 64) + lane;
        if (wave & 1) {
            const float i2 = lam / lsum;
#pragma unroll
            for (int d0 = 0; d0 < ND; ++d0)
#pragma unroll
                for (int i = 0; i < 16; ++i) xb[(d0 * 16 + i) * 64] = O[d0][i] * i2;
        }
        __syncthreads();
        if (!(wave & 1)) {
            const float i1 = 1.f / lsum;
            float ssq = 0.f;
#pragma unroll
            for (int d0 = 0; d0 < ND; ++d0)
#pragma unroll
                for (int i = 0; i < 16; ++i) { const float y = O[d0][i] * i1 - xb[(d0 * 16 + i) * 64]; O[d0][i] = y; ssq += y * y; }
            ssq = half_sum(ssq);
            const float rn = (1.0f / sqrtf(ssq * (1.f / DV) + EPS)) * (1.f - LAMBDA_INIT);
#pragma unroll
            for (int d0 = 0; d0 < ND; ++d0)
#pragma unroll
                for (int g4 = 0; g4 < 4; ++g4) {
                    const int d = 32 * d0 + 8 * g4;
                    const f32x4 gv = *(const f32x4*)(subg + d + 4 * h);
                    u32x2 w; w.x = cvtpk(O[d0][4 * g4 + 0] * rn * gv.x, O[d0][4 * g4 + 1] * rn * gv.y); w.y = cvtpk(O[d0][4 * g4 + 2] * rn * gv.z, O[d0][4 * g4 + 3] * rn * gv.w);
                    *(u32x2*)(yrow + d) = w;
                }
        }
        __syncthreads();
    } else {
        const float i1 = 1.f / lsum;
#pragma unroll
        for (int d0 = 0; d0 < ND; ++d0)
#pragma unroll
            for (int g4 = 0; g4 < 4; ++g4) {
                const int d = 32 * d0 + 8 * g4;
                u32x2 w; w.x = cvtpk(O[d0][4 * g4 + 0] * i1, O[d0][4 * g4 + 1] * i1); w.y = cvtpk(O[d0][4 * g4 + 2] * i1, O[d0][4 * g4 + 3] * i1);
                *(u32x2*)(yrow + d) = w;
            }
    }
}

using pg8::Unit;
#define EPI_LOOP_ROWS for (int ai = 0; ai < 2; ++ai) _Pragma("unroll") for (int m = 0; m < 4; ++m)
__device__ __forceinline__ u32x4 pack8(const f32x4& a, const f32x4& b) { u32x4 w; w.x = cvtpk(a[0], a[1]); w.y = cvtpk(a[2], a[3]); w.z = cvtpk(b[0], b[1]); w.w = cvtpk(b[2], b[3]); return w; }
__device__ __forceinline__ void unpack8(const u32x4& w, f32x4& a, f32x4& b) {
    a[0] = __uint_as_float(w.x << 16); a[1] = __uint_as_float(w.x & 0xffff0000u); a[2] = __uint_as_float(w.y << 16); a[3] = __uint_as_float(w.y & 0xffff0000u);
    b[0] = __uint_as_float(w.z << 16); b[1] = __uint_as_float(w.z & 0xffff0000u); b[2] = __uint_as_float(w.w << 16); b[3] = __uint_as_float(w.w & 0xffff0000u); }

struct EpiProj {
    static constexpr bool PERM = true, AFTER_DRAIN = false, HAS_MID = false;
    bf16_t* O; const float* rstd; unsigned char* ws;
    __device__ __forceinline__ void operator()(const f32x4 (&acc)[2][2][4][2], const Unit& u, int wr, int wc, int fr, int fq) const {
        const int pn = u.pn; const bool isq = (pn < 2) || (pn == 6) || (pn == 7), isg = pn >= 9, iskv = !isq && !isg;
        const int cin = wc * 32 + 8 * fq;
        int pcol = 0;
        if (pn < 2) pcol = C_QA + pn * 256; else if (pn == 6 || pn == 7) pcol = C_QB + (pn - 6) * 256; else if (pn >= 13) pcol = C_GB + (pn - 13) * 256; else if (pn >= 9) pcol = C_GA + (pn - 9) * 256;
#pragma unroll
        EPI_LOOP_ROWS { const int row = u.pm * 256 + ai * 128 + wr * 64 + m * 16 + fr; float rs = rstd[row]; if (isq) rs *= QSCALE;
#pragma unroll
            for (int bj = 0; bj < 2; ++bj) { f32x4 a = acc[ai][bj][m][0] * rs, c = acc[ai][bj][m][1] * rs;
                if (isg) {
#pragma unroll
                    for (int j = 0; j < 4; ++j) { a[j] = sigmoidf_(a[j]); c[j] = sigmoidf_(c[j]); } }
                const u32x4 w = pack8(a, c);
                if (!iskv) { *(u32x4*)(O + (size_t)row * PROJ_W + pcol + bj * 128 + cin) = w; }
                else {
                    const bool meta = row >= M_REAL; const int bb = row >> 12, tt = row & 4095, mr = row - M_REAL;
                    if (meta && mr >= 64) continue;
                    bf16_t* dst;
                    if (pn == 8) { const int g = cin >> 6, cc = cin & 63;
                        if (meta) dst = (bf16_t*)(ws + (bj ? WS_VBM : WS_KBM)) + ((size_t)g * 64 + mr) * 64 + cc;
                        else dst = (bf16_t*)(ws + (bj ? WS_VB : WS_KB)) + (((size_t)bb * 2 + g) * 4096 + tt) * 64 + cc;
                    } else { const bool isv = pn >= 4; const int hh = 2 * (pn - (isv ? 4 : 2)) + bj;
                        if (meta) dst = (bf16_t*)(ws + (isv ? WS_VAM : WS_KAM)) + ((size_t)hh * 64 + mr) * 128 + cin;
                        else dst = (bf16_t*)(ws + (isv ? WS_VA : WS_KA)) + (((size_t)bb * 4 + hh) * 4096 + tt) * 128 + cin; }
                    *(u32x4*)dst = w; } } }
        if (pn == 2 || pn == 3) {
            float* kpart = (float*)(ws + WS_STAT) + M_PAD + 2 * M_REAL;
            const bool metat = u.pm * 256 >= M_REAL; const int bb = (u.pm * 256) >> 12;
#pragma unroll
            for (int bj = 0; bj < 2; ++bj) {
                float mx = 0.f;
#pragma unroll
                EPI_LOOP_ROWS { const int row = u.pm * 256 + ai * 128 + wr * 64 + m * 16 + fr; const float rs = rstd[row];
                    const f32x4 a = acc[ai][bj][m][0] * rs, c = acc[ai][bj][m][1] * rs;
                    float pt = (a[0] * a[0] + a[1] * a[1]) + (a[2] * a[2] + a[3] * a[3]) + (c[0] * c[0] + c[1] * c[1]) + (c[2] * c[2] + c[3] * c[3]);
                    pt += __shfl_xor(pt, 16); pt += __shfl_xor(pt, 32);
                    mx = fmaxf(mx, pt); }
                mx = fmaxf(mx, __shfl_xor(mx, 1)); mx = fmaxf(mx, __shfl_xor(mx, 2)); mx = fmaxf(mx, __shfl_xor(mx, 4)); mx = fmaxf(mx, __shfl_xor(mx, 8));
                if (fr == 0 && fq == 0) { const int hh = 2 * (pn - 2) + bj;
                    atomicMax((unsigned*)kpart + (((metat ? 32 + hh : bb * 4 + hh) * 2 + (wc >> 1)) * 2 + (wc & 1)), __float_as_uint(mx)); }
            }
        }
    }
};
struct EpiGate1 {
    static constexpr bool PERM = true, AFTER_DRAIN = false, HAS_MID = false;
    bf16_t* T; const bf16_t* proj;
    __device__ __forceinline__ void operator()(const f32x4 (&acc)[2][2][4][2], const Unit& u, int wr, int wc, int fr, int fq) const {
        const int col0 = u.pn * 256 + wc * 32 + 8 * fq;
#pragma unroll
        for (int ai = 0; ai < 2; ++ai) {
            u32x4 g[4][2];
#pragma unroll
            for (int m = 0; m < 4; ++m)
#pragma unroll
                for (int bj = 0; bj < 2; ++bj) g[m][bj] = *(const u32x4*)(proj + (size_t)(u.pm * 256 + ai * 128 + wr * 64 + m * 16 + fr) * PROJ_W + C_GA + col0 + bj * 128);
#pragma unroll
            for (int m = 0; m < 4; ++m) { const int row = u.pm * 256 + ai * 128 + wr * 64 + m * 16 + fr;
#pragma unroll
                for (int bj = 0; bj < 2; ++bj) { f32x4 ga, gb; unpack8(g[m][bj], ga, gb);
                    *(u32x4*)(T + (size_t)row * D_MODEL + col0 + bj * 128) = pack8(acc[ai][bj][m][0] * ga, acc[ai][bj][m][1] * gb); } }
        }
    }
};
struct EpiGate2 {
    static constexpr bool PERM = true, AFTER_DRAIN = false, HAS_MID = false;
    const bf16_t* T; const bf16_t* proj; bf16_t* Mg;
    __device__ __forceinline__ void operator()(const f32x4 (&acc)[2][2][4][2], const Unit& u, int wr, int wc, int fr, int fq) const {
        const int col0 = u.pn * 256 + wc * 32 + 8 * fq;
#pragma unroll
        for (int ai = 0; ai < 2; ++ai) {
            u32x4 g[4][2], tq[4][2];
#pragma unroll
            for (int m = 0; m < 4; ++m)
#pragma unroll
                for (int bj = 0; bj < 2; ++bj) { const size_t row = (size_t)(u.pm * 256 + ai * 128 + wr * 64 + m * 16 + fr);
                    g[m][bj] = *(const u32x4*)(proj + row * PROJ_W + C_GB + col0 + bj * 128); tq[m][bj] = *(const u32x4*)(T + row * D_MODEL + col0 + bj * 128); }
#pragma unroll
            for (int m = 0; m < 4; ++m) { const int row = u.pm * 256 + ai * 128 + wr * 64 + m * 16 + fr;
#pragma unroll
                for (int bj = 0; bj < 2; ++bj) { f32x4 ga, gb, t0, t1; unpack8(g[m][bj], ga, gb); unpack8(tq[m][bj], t0, t1);
                    *(u32x4*)(Mg + (size_t)row * D_MODEL + col0 + bj * 128) = pack8(t0 + acc[ai][bj][m][0] * ga, t1 + acc[ai][bj][m][1] * gb); } }
        }
    }
};
struct EpiGateFused {
    static constexpr bool PERM = true, AFTER_DRAIN = false, HAS_MID = true;
    const bf16_t* proj; bf16_t* Mg;
    __device__ __forceinline__ void operator()(f32x4 (&acc)[2][2][4][2], const Unit& u, int wr, int wc, int fr, int fq) const {
        const int col0 = u.pn * 256 + wc * 32 + 8 * fq;
        if (u.kh == 0) {
#pragma unroll
            for (int ai = 0; ai < 2; ++ai) {
                u32x4 ga[4][2], gb[4][2];
#pragma unroll
                for (int m = 0; m < 4; ++m)
#pragma unroll
                    for (int bj = 0; bj < 2; ++bj) { const bf16_t* gp = proj + (size_t)(u.pm * 256 + ai * 128 + wr * 64 + m * 16 + fr) * PROJ_W + col0 + bj * 128;
                        ga[m][bj] = *(const u32x4*)(gp + C_GA); gb[m][bj] = *(const u32x4*)(gp + C_GB); }
#pragma unroll
                for (int m = 0; m < 4; ++m)
#pragma unroll
                    for (int bj = 0; bj < 2; ++bj) { f32x4 a0, a1, b0, b1; unpack8(ga[m][bj], a0, a1); unpack8(gb[m][bj], b0, b1);
#pragma unroll
                        for (int j = 0; j < 4; ++j) { acc[ai][bj][m][0][j] *= a0[j] * __builtin_amdgcn_rcpf(fmaxf(b0[j], 1e-30f)); acc[ai][bj][m][1][j] *= a1[j] * __builtin_amdgcn_rcpf(fmaxf(b1[j], 1e-30f)); } }
            }
        } else {
#pragma unroll
            for (int ai = 0; ai < 2; ++ai) {
                u32x4 gb[4][2];
#pragma unroll
                for (int m = 0; m < 4; ++m)
#pragma unroll
                    for (int bj = 0; bj < 2; ++bj) gb[m][bj] = *(const u32x4*)(proj + (size_t)(u.pm * 256 + ai * 128 + wr * 64 + m * 16 + fr) * PROJ_W + C_GB + col0 + bj * 128);
#pragma unroll
                for (int m = 0; m < 4; ++m) { const int row = u.pm * 256 + ai * 128 + wr * 64 + m * 16 + fr;
#pragma unroll
                    for (int bj = 0; bj < 2; ++bj) { f32x4 b0, b1; unpack8(gb[m][bj], b0, b1);
                        *(u32x4*)(Mg + (size_t)row * D_MODEL + col0 + bj * 128) = pack8(acc[ai][bj][m][0] * b0, acc[ai][bj][m][1] * b1); } }
            }
        }
    }
};
struct SplitK2Order {
    pg8::StaticOrder base;
    __device__ bool next(int i, Unit& u) const { if (!base.next(i >> 1, u)) return false; u.kh = i & 1; return true; }
    __device__ __forceinline__ void a_ready(const Unit&) const {}
    __device__ __forceinline__ void done(const Unit&) const {}
};
template <bool BASE_BF16> struct EpiResid {
    static constexpr bool PERM = true, AFTER_DRAIN = false, HAS_MID = false;
    const void* base; bf16_t* ob; float* sumsq;
    __device__ __forceinline__ void operator()(const f32x4 (&acc)[2][2][4][2], const Unit& u, int wr, int wc, int fr, int fq) const {
        const int col0 = u.pn * 256 + wc * 32 + 8 * fq;
#pragma unroll
        for (int ai = 0; ai < 2; ++ai)
#pragma unroll
            for (int mh = 0; mh < 4; mh += 2) {
                f32x4 pre[2][2][2];
#pragma unroll
                for (int mm = 0; mm < 2; ++mm)
#pragma unroll
                    for (int bj = 0; bj < 2; ++bj) { const size_t off = (size_t)(u.pm * 256 + ai * 128 + wr * 64 + (mh + mm) * 16 + fr) * D_MODEL + col0 + bj * 128;
                        if (BASE_BF16) unpack8(*(const u32x4*)((const bf16_t*)base + off), pre[mm][bj][0], pre[mm][bj][1]);
                        else { pre[mm][bj][0] = *(const f32x4*)((const float*)base + off); pre[mm][bj][1] = *(const f32x4*)((const float*)base + off + 4); } }
#pragma unroll
                for (int mm = 0; mm < 2; ++mm) { const int m = mh + mm, row = u.pm * 256 + ai * 128 + wr * 64 + m * 16 + fr; float ss = 0.f;
#pragma unroll
                    for (int bj = 0; bj < 2; ++bj) { const size_t off = (size_t)row * D_MODEL + col0 + bj * 128;
                        const f32x4 a = pre[mm][bj][0] + acc[ai][bj][m][0], c = pre[mm][bj][1] + acc[ai][bj][m][1];
                        *(u32x4*)(ob + off) = pack8(a, c);
                        ss += (a[0] * a[0] + a[1] * a[1]) + (a[2] * a[2] + a[3] * a[3]) + (c[0] * c[0] + c[1] * c[1]) + (c[2] * c[2] + c[3] * c[3]); }
                    ss += __shfl_xor(ss, 16); ss += __shfl_xor(ss, 32);
                    if (fq == 0) atomicAdd(sumsq + row, ss); }
            }
    }
};
struct EpiSwiglu {
    static constexpr bool PERM = true, AFTER_DRAIN = false, HAS_MID = false;
    bf16_t* act; const float* sumsq;
    __device__ __forceinline__ void operator()(const f32x4 (&acc)[2][2][4][2], const Unit& u, int wr, int wc, int fr, int fq) const {
        const int col0 = u.pn * 128 + wc * 32 + 8 * fq;
#pragma unroll
        EPI_LOOP_ROWS { const int row = u.pm * 256 + ai * 128 + wr * 64 + m * 16 + fr; const float rs = __builtin_amdgcn_rsqf(sumsq[row] * (1.f / D_MODEL) + EPS);
            f32x4 o[2];
#pragma unroll
            for (int n = 0; n < 2; ++n)
#pragma unroll
                for (int j = 0; j < 4; ++j) { const float g = acc[ai][0][m][n][j] * rs, up = acc[ai][1][m][n][j] * rs; o[n][j] = g * sigmoidf_(g) * up; }
            *(u32x4*)(act + (size_t)row * D_FF + col0) = pack8(o[0], o[1]); }
    }
};

#define XB_TMO      128
#define XB_XCNT(j)  (256  + 64 * (j))
#define XB_XSUB(j)  (1280 + 64 * (j))
#define XB_XGEN(j)  (2304 + 64 * (j))
#define XB_TOP      3328
#define XB_TOPGEN   3392
#define XCD_BAR_WORDS 3456
#define XB_SPIN_CAP (1u << 18)

__device__ __forceinline__ unsigned xb_ld(unsigned* p)              { return __hip_atomic_load(p, __ATOMIC_RELAXED, __HIP_MEMORY_SCOPE_AGENT); }
__device__ __forceinline__ unsigned xb_add(unsigned* p, unsigned v) { return __hip_atomic_fetch_add(p, v, __ATOMIC_RELAXED, __HIP_MEMORY_SCOPE_AGENT); }
__device__ __forceinline__ unsigned xb_xcc_id() { return (unsigned)__builtin_amdgcn_s_getreg((3 << 11) | 20) & 0xFu; }
#define XB_SPIN(cond, bar) do { unsigned _sp = 0; while (cond) { __builtin_amdgcn_s_sleep(1); \
    if ((++_sp & 255u) == 0u) { if (xb_ld(&(bar)[XB_TMO])) break; if (_sp > XB_SPIN_CAP) { atomicAdd(&(bar)[XB_TMO], 1u); break; } } } } while (0)

struct XcdBarrier {
    unsigned* bar; unsigned x;
    volatile LAS unsigned* st;
};

__device__ __forceinline__ XcdBarrier xcd_barrier_post(unsigned* bar, volatile LAS unsigned* st) {
    XcdBarrier b; b.bar = bar; b.x = xb_xcc_id(); b.st = st;
    if (threadIdx.x == 0) (void)xb_add(&bar[XB_XCNT(b.x)], 1u);
    return b;
}
__device__ __forceinline__ void xcd_barrier_complete(unsigned* bar, unsigned x, unsigned& nloc, unsigned& nx) {
    const unsigned G = gridDim.x * gridDim.y * gridDim.z;
    unsigned sum, cnt, mine, sp = 0u;
    for (;;) {
        sum = 0u; cnt = 0u; mine = 0u;
#pragma unroll
        for (unsigned j = 0; j < 16; ++j) { const unsigned c = xb_ld(&bar[XB_XCNT(j)]); sum += c; cnt += (c > 0u) ? 1u : 0u; mine = (j == x) ? c : mine; }
        if (sum == G) break;
        __builtin_amdgcn_s_sleep(1);
        if ((++sp & 255u) == 0u) { if (xb_ld(&bar[XB_TMO])) break; if (sp > XB_SPIN_CAP) { atomicAdd(&bar[XB_TMO], 1u); break; } }
    }
    nloc = mine > 0u ? mine : 1u; nx = cnt > 0u ? cnt : 1u;
}

__device__ __forceinline__ void xcd_barrier(const XcdBarrier& b) {
    asm volatile("s_waitcnt vmcnt(0)" ::: "memory");
    __syncthreads();
    if (threadIdx.x == 0) {
        unsigned* bar = b.bar;
        __builtin_amdgcn_s_waitcnt(0);
        unsigned nloc = b.st[0], nx = b.st[1];
        if (nloc == 0u) { xcd_barrier_complete(bar, b.x, nloc, nx); b.st[0] = nloc; b.st[1] = nx; }
        const unsigned old = xb_add(&bar[XB_XSUB(b.x)], 1u);
        const unsigned gen = old / nloc;
        if (old + 1u == (gen + 1u) * nloc) {
            __builtin_amdgcn_fence(__ATOMIC_RELEASE, "agent");
            asm volatile("s_waitcnt vmcnt(0)" ::: "memory");
            const unsigned og = xb_add(&bar[XB_TOP], 1u);
            const unsigned tg = og / nx;
            if (og + 1u == (tg + 1u) * nx) xb_add(&bar[XB_TOPGEN], 1u);
            else XB_SPIN(xb_ld(&bar[XB_TOPGEN]) == tg, bar);
            __builtin_amdgcn_fence(__ATOMIC_ACQUIRE, "agent");
            xb_add(&bar[XB_XGEN(b.x)], 1u);
            asm volatile("s_waitcnt vmcnt(0)" ::: "memory");
        } else {
            XB_SPIN(xb_ld(&bar[XB_XGEN(b.x)]) == gen, bar);
            __builtin_amdgcn_fence(__ATOMIC_ACQUIRE, "agent");
            asm volatile("s_waitcnt vmcnt(0)" ::: "memory");
        }
    }
    __syncthreads();
}


__global__ void __launch_bounds__(512) fwd_megakernel(Params p) {
    __shared__ __attribute__((aligned(16))) unsigned char smem[LDS_BYTES];
    cg::grid_group grid = cg::this_grid();
    LAS unsigned char* lds = (LAS unsigned char*)smem;
    const int tid = threadIdx.x, lane = tid & 63, wave = __builtin_amdgcn_readfirstlane(tid >> 6);
    const int G = gridDim.x, bx = blockIdx.x;
    const int vcu = (G % 8 == 0) ? (bx % 8) * (G / 8) + bx / 8 : bx;
    const int gw = bx * 8 + wave, NGW = G * 8;
    unsigned char* ws = p.ws;
    bf16_t* W_in = (bf16_t*)(ws + WS_WIN); bf16_t* W_ba = (bf16_t*)(ws + WS_WBA); bf16_t* W_bb = (bf16_t*)(ws + WS_WBB); bf16_t* W_o = (bf16_t*)(ws + WS_WO);
    bf16_t* W_gu = (bf16_t*)(ws + WS_WGU); bf16_t* W_d = (bf16_t*)(ws + WS_WD);
    float* rstd1 = (float*)(ws + WS_STAT); float* sumsq1 = rstd1 + M_PAD; float* sumsq2 = sumsq1 + M_REAL;
    bf16_t* HB = (bf16_t*)(ws + WS_A); bf16_t* MERGED = (bf16_t*)(ws + WS_KA);
    bf16_t* YA = (bf16_t*)(ws + WS_Y); bf16_t* YB = YA + 512; bf16_t* H1B = YA;
    bf16_t* PROJ = (bf16_t*)(ws + WS_P); bf16_t* ACT = PROJ;

    volatile LAS unsigned* bst = (volatile LAS unsigned*)(lds + 131072 + 64);
    if (tid < 2) bst[tid] = 0u;
    unsigned* barw = (unsigned*)(ws + WS_BAR);
    if (bx == 0) for (int i = tid; i < XCD_BAR_WORDS; i += 512) barw[i] = 0u;
    p0_prologue(p, lds, gw, NGW, wave, lane);
    grid.sync();
    (void)xcd_barrier_post(barw, bst);

    { pg8::Gemm g{HB, W_in, M_PAD, PROJ_N, 1024}; pg8::StaticOrder S; S.init(M_PAD, PROJ_N, G, bx);
      EpiProj E{PROJ, rstd1, ws};
      pg8::gemm_phase<EpiProj, pg8::StaticOrder, true, true>(lds, g, S, E); }
    {
        const int nwg = (M_PAD / 256) * (PROJ_N / 256), rounds = (nwg + G - 1) / G, first_idle = nwg - (rounds - 1) * G, n_idle = G - first_idle;
        if (n_idle <= 0) weight_items(p, lds, W_ITEMS_EARLY, W_ITEMS, gw, NGW, wave, lane);
        else if (bx >= first_idle) weight_items(p, lds, W_ITEMS_EARLY, W_ITEMS, (bx - first_idle) * 8 + wave, n_idle * 8, wave, lane);
    }
    { XcdBarrier xb_; xb_.bar = (unsigned*)(p.ws + WS_BAR); xb_.x = xb_xcc_id(); xb_.st = bst; xcd_barrier(xb_); }

    {
        float lam;
        { const float a = wave_sum(p.lq1[lane] * p.lk1[lane]), c = wave_sum(p.lq2[lane] * p.lk2[lane]); lam = expf(a) - expf(c) + LAMBDA_INIT; }
        for (int u = vcu; u < 1024; u += G) {
            const int g_ = (u & 255) >> 5, r_ = u >> 8, b = 2 * r_ + (g_ >> 2), hh = (g_ + r_) & 3, bh = b * 4 + hh, qblk = u & 31, X = wave & 1;
            const float sl2 = exp2f(-2.f * (float)(hh + 1)) * LOG2E;
            int kt_a = 0, kt_b = 64; float mfix;
            {
                const bf16_t* qp = PROJ + (size_t)(b * SEQ + qblk * 128 + (wave >> 1) * 32 + (lane & 31)) * PROJ_W + C_QA + hh * 128 + X * 64 + 8 * (lane >> 5);
                float q2 = 0.f;
#pragma unroll
                for (int ks = 0; ks < 4; ++ks) { const bf16x8 qv = *(const bf16x8*)(qp + 16 * ks);
#pragma unroll
                    for (int j = 0; j < 8; ++j) { const float f = bf2f((unsigned short)qv[j]); q2 += f * f; } }
                q2 = half_sum(q2);
#pragma unroll
                for (int o = 1; o < 32; o <<= 1) q2 = fmaxf(q2, __shfl_xor(q2, o));
                LAS float* xq = (LAS float*)(lds + 131072 + 256);
                if (lane == 0) xq[wave] = q2;
                __syncthreads();
                float qm = xq[0];
#pragma unroll
                for (int w = 1; w < 8; ++w) qm = fmaxf(qm, xq[w]);
                __syncthreads();
                const float* kpart = (const float*)(ws + WS_STAT) + M_PAD + 2 * M_REAL;
                float km = 0.f;
#pragma unroll
                for (int xx = 0; xx < 2; ++xx) { km = fmaxf(km, kpart[(bh * 2 + xx) * 2] + kpart[(bh * 2 + xx) * 2 + 1]); km = fmaxf(km, kpart[((32 + hh) * 2 + xx) * 2] + kpart[((32 + hh) * 2 + xx) * 2 + 1]); }
                const float Bq = sqrtf(qm * km) * 1.02f;
                mfix = fminf(Bq, 60.f);
                const float D = (70.f + 2.f * Bq) / sl2;
                if (D < 8192.f) { const int Di = (int)D + 1; const int lo = (qblk * 128 - 63 - Di), hi = (qblk * 128 + 127 + Di);
                    kt_a = lo <= 0 ? 0 : (lo + 63) >> 6; kt_b = (hi >> 6) + 1 > 64 ? 64 : (hi >> 6) + 1; }
            }
            attn_unit<128, 128, false, true>(lds, PROJ, b, (const bf16_t*)(ws + WS_KA) + (size_t)bh * 4096 * 128, (const bf16_t*)(ws + WS_VA) + (size_t)bh * 4096 * 128,
                                             (const bf16_t*)(ws + WS_KAM) + hh * 64 * 128, (const bf16_t*)(ws + WS_VAM) + hh * 64 * 128, X * 64, kt_a, kt_b,
                                             C_QA + hh * 128 + X * 64, qblk * 128 + (wave >> 1) * 32, sl2, mfix, 0.f, true, YA, hh * 128, lam, p.subln);
        }
        for (int u = vcu; u < 1024; u += G) {
            const int bg = u >> 6, b = bg >> 1, g = bg & 1, qb = u & 63, head = g * 4 + (wave >> 1);
            const float sl2 = exp2f(-(float)(head + 1)) * LOG2E, sink2 = p.sink[head] * LOG2E;
            const int kt_lo = qb - 2 < 0 ? 0 : qb - 2, kt_hi = qb + 3 > 64 ? 64 : qb + 3;
            attn_unit<64, 64, true, false>(lds, PROJ, b, (const bf16_t*)(ws + WS_KB) + (size_t)bg * 4096 * 64, (const bf16_t*)(ws + WS_VB) + (size_t)bg * 4096 * 64,
                                           (const bf16_t*)(ws + WS_KBM) + g * 64 * 64, (const bf16_t*)(ws + WS_VBM) + g * 64 * 64, 0, kt_lo, kt_hi,
                                           C_QB + head * 64, qb * 64 + (wave & 1) * 32, sl2, sink2, 1.f, true, YB, head * 64, 0.f, nullptr);
        }
    }
    { XcdBarrier xb_; xb_.bar = (unsigned*)(p.ws + WS_BAR); xb_.x = xb_xcc_id(); xb_.st = bst; xcd_barrier(xb_); }

    { pg8::Gemm g{YA, W_ba, M_REAL, 1024, 512, 1024}; SplitK2Order S; S.base.init(M_REAL, 1024, G, bx);
      EpiGateFused E{PROJ, MERGED};
      pg8::gemm_phase<EpiGateFused, SplitK2Order, true, true>(lds, g, S, E); }
    { XcdBarrier xb_; xb_.bar = (unsigned*)(p.ws + WS_BAR); xb_.x = xb_xcc_id(); xb_.st = bst; xcd_barrier(xb_); }

    { pg8::Gemm g{MERGED, W_o, M_REAL, 1024, 1024}; pg8::StaticOrder S; S.init(M_REAL, 1024, G, bx);
      EpiResid<true> E{HB, H1B, sumsq1};
      pg8::gemm_phase<EpiResid<true>, pg8::StaticOrder, true, true>(lds, g, S, E); }
    { XcdBarrier xb_; xb_.bar = (unsigned*)(p.ws + WS_BAR); xb_.x = xb_xcc_id(); xb_.st = bst; xcd_barrier(xb_); }

    { pg8::Gemm g{H1B, W_gu, M_REAL, 2 * D_FF, 1024}; pg8::StaticOrder S; S.init(M_REAL, 2 * D_FF, G, bx);
      EpiSwiglu E{ACT, sumsq1};
      pg8::gemm_phase<EpiSwiglu, pg8::StaticOrder, true, true>(lds, g, S, E); }
    { XcdBarrier xb_; xb_.bar = (unsigned*)(p.ws + WS_BAR); xb_.x = xb_xcc_id(); xb_.st = bst; xcd_barrier(xb_); }

    bf16_t* H2B = HB;
    { pg8::Gemm g{ACT, W_d, M_REAL, 1024, D_FF}; pg8::StaticOrder S; S.init(M_REAL, 1024, G, bx);
      EpiResid<true> E{H1B, H2B, sumsq2};
      pg8::gemm_phase<EpiResid<true>, pg8::StaticOrder, true, true>(lds, g, S, E); }
    { XcdBarrier xb_; xb_.bar = (unsigned*)(p.ws + WS_BAR); xb_.x = xb_xcc_id(); xb_.st = bst; xcd_barrier(xb_); }

    {
        int t6_ = threadIdx.x; asm volatile("" : "+v"(t6_));
        const int lane = t6_ & 63;
        const f32x4* gp = (const f32x4*)p.norm_final + 2 * lane;
        f32x4 gv[2][2];
#pragma unroll
        for (int j = 0; j < 2; ++j) { gv[j][0] = gp[128 * j]; gv[j][1] = gp[128 * j + 1]; }
        for (int m0 = gw; m0 < M_REAL; m0 += 4 * NGW) {
            u32x4 v[4][2]; float rs[4];
#pragma unroll
            for (int q = 0; q < 4; ++q) { const int m = (m0 + q * NGW < M_REAL) ? m0 + q * NGW : m0; const u32x4* hp = (const u32x4*)(H2B + (size_t)m * D_MODEL) + lane;
                rs[q] = sumsq2[m];
#pragma unroll
                for (int j = 0; j < 2; ++j) v[q][j] = hp[64 * j]; }
#pragma unroll
            for (int q = 0; q < 4; ++q) { const int m = m0 + q * NGW; if (m >= M_REAL) break;
                const float r = __builtin_amdgcn_rsqf(rs[q] * (1.f / D_MODEL) + EPS); f32x4* o = (f32x4*)(p.out + (size_t)m * D_MODEL) + 2 * lane;
#pragma unroll
                for (int j = 0; j < 2; ++j) { f32x4 a, c; unpack8(v[q][j], a, c); o[128 * j] = a * r * gv[j][0]; o[128 * j + 1] = c * r * gv[j][1]; } }
        }
    }
}

extern "C" void kernel_launch(void* const* d_in, const int* in_sizes, int n_in, void* d_out, int out_size, void* d_ws, size_t ws_size, hipStream_t stream) {
    static int grid_blocks = 0;
    if (!grid_blocks) {
        if (n_in != 18 || in_sizes[0] != M_REAL * D_MODEL || out_size != M_REAL * D_MODEL || ws_size < WS_END) {
            fprintf(stderr, "kernel_launch: unexpected shapes (n_in %d, in0 %d, out %d, ws %zu); nothing launched\n", n_in, n_in > 0 ? in_sizes[0] : -1, out_size, ws_size); grid_blocks = -1; return; }
        int dev = 0, cus = 0, per_cu = 0;
        hipGetDevice(&dev);
        hipDeviceGetAttribute(&cus, hipDeviceAttributeMultiprocessorCount, dev);
        hipOccupancyMaxActiveBlocksPerMultiprocessor(&per_cu, (const void*)fwd_megakernel, 512, 0);
        if (per_cu < 1) { fprintf(stderr, "kernel_launch: occupancy query says %d blocks/CU\n", per_cu); per_cu = 1; }
        grid_blocks = cus * per_cu;
    }
    if (grid_blocks < 0) return;
    Params p{};
    p.x = (const float*)d_in[0]; p.meta = (const float*)d_in[1]; p.norm_mix = (const float*)d_in[2]; p.w_in = (const float*)d_in[3];
    p.lq1 = (const float*)d_in[4]; p.lk1 = (const float*)d_in[5]; p.lq2 = (const float*)d_in[6]; p.lk2 = (const float*)d_in[7];
    p.subln = (const float*)d_in[8]; p.sink = (const float*)d_in[9]; p.w_ba = (const float*)d_in[10]; p.w_bb = (const float*)d_in[11]; p.w_o = (const float*)d_in[12];
    p.norm_ffn = (const float*)d_in[13]; p.w_g = (const float*)d_in[14]; p.w_u = (const float*)d_in[15]; p.w_d = (const float*)d_in[16]; p.norm_final = (const float*)d_in[17];
    p.out = (float*)d_out; p.ws = (unsigned char*)d_ws;
    void* args[] = {&p};
    hipError_t e = hipLaunchCooperativeKernel((const void*)fwd_megakernel, dim3(grid_blocks), dim3(512), args, 0, stream);
    if (e != hipSuccess) fprintf(stderr, "cooperative launch failed: %s (grid %d)\n", hipGetErrorString(e), grid_blocks);
}
```
